# Optimizing an MI355X kernel written in HIP

```python
import math
import jax, jax.numpy as jnp
from jax import lax
import numpy as np

D_MODEL = 1024
BATCH = 4
SEQ = 8192
DEPTH = 1

D_MIX = D_MODEL
D_POOL = D_MIX // 2
POOL_WINDOWS = (2, 4, 8, 16)
N_POOL_GROUPS = len(POOL_WINDOWS)
POOL_GROUP = D_POOL // N_POOL_GROUPS
D_GMLP = D_MIX - D_POOL
N_GMLP_HEADS = 8
GMLP_HEAD = D_GMLP // N_GMLP_HEADS
CHUNK = 128
D_FF = 2816
N_SUB = 3
N_MOD = 3
EPS = 1e-6
HALF_STEP = 0.5

kernel_name = "hybrid_pool_gmlp_macaron_adaln"


def rms_norm(x, g):
    xf = x.astype(jnp.float32)
    r = lax.rsqrt(jnp.mean(xf * xf, axis=-1, keepdims=True) + EPS)
    return (xf * r).astype(x.dtype) * g


def layer_norm(x, g, b):
    xf = x.astype(jnp.float32)
    mu = jnp.mean(xf, axis=-1, keepdims=True)
    var = jnp.mean(jnp.square(xf - mu), axis=-1, keepdims=True)
    return ((xf - mu) * lax.rsqrt(var + EPS)).astype(x.dtype) * g + b


def modulate(h, shift, scale):
    return h * (1.0 + scale[:, None, :]) + shift[:, None, :]


def swiglu(h, w_in, w_out):
    gu = h @ w_in
    g, u = jnp.split(gu, 2, axis=-1)
    return (jax.nn.silu(g) * u) @ w_out


def causal_multiscale_pool(xp, w_pool, pool_scale):
    B, S, _ = xp.shape
    xg = xp.reshape(B, S, N_POOL_GROUPS, POOL_GROUP)
    xf = xg.astype(jnp.float32)
    cs = jnp.cumsum(xf, axis=1)
    pos = jnp.arange(S, dtype=jnp.int32)
    outs = []
    for i, w in enumerate(POOL_WINDOWS):
        c_i = cs[:, :, i]
        c_prev = jnp.pad(c_i[:, :-w], ((0, 0), (w, 0), (0, 0)))
        cnt = jnp.minimum(pos + 1, w).astype(jnp.float32)[None, :, None]
        outs.append((c_i - c_prev) / cnt - xf[:, :, i])
    pooled = jnp.stack(outs, axis=2).astype(xp.dtype)
    mixed = jnp.einsum('bsgc,gcd->bsgd', pooled, w_pool)
    return mixed.reshape(B, S, D_POOL) * pool_scale


def chunked_spatial_gating(zb, ln_g, ln_b, w_spatial, b_spatial):
    B, S, _ = zb.shape
    z = jax.nn.gelu(zb)
    u, v = jnp.split(z, 2, axis=-1)
    v = layer_norm(v, ln_g, ln_b)
    vc = v.reshape(B, S // CHUNK, CHUNK, N_GMLP_HEADS, GMLP_HEAD)
    mask = jnp.tril(jnp.ones((CHUNK, CHUNK), dtype=bool))
    ws = jnp.where(mask[None], w_spatial, jnp.zeros((), w_spatial.dtype))
    sv = jnp.einsum('hts,bnshc->bnthc', ws, vc)
    sv = sv + jnp.transpose(b_spatial)[None, None, :, :, None]
    return u * sv.reshape(B, S, D_GMLP)


def setup_inputs(seed: int = 0) -> dict:
    key = jax.random.key(seed)
    ks = jax.random.split(key, 24)
    f32 = jnp.float32
    L, D = DEPTH, D_MODEL

    def nrm(k, shape, fan_in):
        return jax.random.normal(k, shape, f32) * (fan_in ** -0.5)

    def gain(k, shape):
        return 1.0 + 0.05 * jax.random.normal(k, shape, f32)

    return {
        "x": jax.random.normal(ks[0], (BATCH, SEQ, D), f32),
        "c": jax.random.normal(ks[1], (BATCH, D), f32),
        "w_ada": nrm(ks[2], (L, D, N_SUB * N_MOD * D), D),
        "b_ada": 0.02 * jax.random.normal(ks[3], (L, N_SUB * N_MOD * D), f32),
        "norm_ffn1_g": gain(ks[4], (L, D)),
        "ffn1_w_in": nrm(ks[5], (L, D, 2 * D_FF), D),
        "ffn1_w_out": nrm(ks[6], (L, D_FF, D), D_FF),
        "norm_mix_g": gain(ks[7], (L, D)),
        "w_mix_in": nrm(ks[8], (L, D, D_POOL + 2 * D_GMLP), D),
        "w_pool": nrm(ks[9], (L, N_POOL_GROUPS, POOL_GROUP, POOL_GROUP), POOL_GROUP),
        "pool_scale": gain(ks[10], (L, D_POOL)),
        "gmlp_ln_g": gain(ks[11], (L, D_GMLP)),
        "gmlp_ln_b": 0.02 * jax.random.normal(ks[12], (L, D_GMLP), f32),
        "w_spatial": nrm(ks[13], (L, N_GMLP_HEADS, CHUNK, CHUNK), CHUNK),
        "b_spatial": gain(ks[14], (L, N_GMLP_HEADS, CHUNK)),
        "w_mix_out": nrm(ks[15], (L, D_MIX, D), D_MIX),
        "norm_ffn2_g": gain(ks[16], (L, D)),
        "ffn2_w_in": nrm(ks[17], (L, D, 2 * D_FF), D),
        "ffn2_w_out": nrm(ks[18], (L, D_FF, D), D_FF),
        "norm_final_g": gain(ks[19], (D,)),
    }


def reference(x, c, w_ada, b_ada, norm_ffn1_g, ffn1_w_in, ffn1_w_out,
              norm_mix_g, w_mix_in, w_pool, pool_scale, gmlp_ln_g, gmlp_ln_b,
              w_spatial, b_spatial, w_mix_out, norm_ffn2_g, ffn2_w_in, ffn2_w_out,
              norm_final_g):
    B = x.shape[0]
    c_act = jax.nn.silu(c)
    for l in range(DEPTH):
        mod = (c_act @ w_ada[l] + b_ada[l]).reshape(B, N_SUB, N_MOD, D_MODEL)

        h = modulate(rms_norm(x, norm_ffn1_g[l]), mod[:, 0, 0], mod[:, 0, 1])
        x = x + HALF_STEP * mod[:, 0, 2][:, None, :] * swiglu(h, ffn1_w_in[l], ffn1_w_out[l])

        h = modulate(rms_norm(x, norm_mix_g[l]), mod[:, 1, 0], mod[:, 1, 1])
        proj = h @ w_mix_in[l]
        xa = proj[..., :D_POOL]
        zb = proj[..., D_POOL:]
        ya = causal_multiscale_pool(xa, w_pool[l], pool_scale[l])
        yb = chunked_spatial_gating(zb, gmlp_ln_g[l], gmlp_ln_b[l], w_spatial[l], b_spatial[l])
        mix = jnp.concatenate([ya, yb], axis=-1) @ w_mix_out[l]
        x = x + mod[:, 1, 2][:, None, :] * mix

        h = modulate(rms_norm(x, norm_ffn2_g[l]), mod[:, 2, 0], mod[:, 2, 1])
        x = x + HALF_STEP * mod[:, 2, 2][:, None, :] * swiglu(h, ffn2_w_in[l], ffn2_w_out[l])
    return rms_norm(x, norm_final_g)
```

```cpp
#include <hip/hip_runtime.h>
#include <hip/hip_cooperative_groups.h>
#include <cstdio>
#include <cstdint>
namespace cg = cooperative_groups;
namespace pg8 {
#define PG8_LAS __attribute__((address_space(3)))
typedef unsigned short bf16_t;
typedef short bf16x8 __attribute__((ext_vector_type(8)));
typedef float f32x4 __attribute__((ext_vector_type(4)));
typedef unsigned u32x4 __attribute__((ext_vector_type(4)));
constexpr int BM = 256, BK = 64, HALF = 128, HTB = HALF * BK * 2  , STAGE_BYTES = 8 * HTB, NXCD = 8, WGM = 8;

__host__ __device__ __forceinline__ int lds_byte(int r, int c) { const int st = (r >> 4) * 2 + (c >> 5), rr = r & 15, cc = c & 31, ob = rr * 64 + cc * 2; return st * 1024 + (ob ^ (((ob >> 9) & 1) << 5)); }
__host__ __device__ __forceinline__ void stage_rc(int b, int& R, int& C) { const int st = b / 1024, sb = b % 1024, swz = sb ^ (((sb >> 9) & 1) << 5); R = (st >> 1) * 16 + swz / 64; C = (st & 1) * 32 + (swz % 64) / 2; }
__host__ __device__ __forceinline__ int perm32(int rho) { const int n = rho >> 4, i = rho & 15; return 8 * (i >> 2) + 4 * n + (i & 3); }

struct Unit { int pm, pn; };
struct Gemm { const bf16_t* A; const bf16_t* Bt; int M, N, K; };

struct StaticOrder {
    int nM, nN, nwg, G, c;
    __host__ __device__ void init(int M, int N, int G_, int c_) { nM = M / BM; nN = N / BM; nwg = nM * nN; G = G_; c = c_; }
    __host__ __device__ bool next(int i, Unit& u) const {
        const long L = (long)i * G + c; if (L >= nwg) return false;
        int wgid = (int)L; { const int q = nwg / NXCD, r = nwg % NXCD, xcd = wgid % NXCD, off = wgid / NXCD; wgid = (xcd < r ? xcd * (q + 1) : r * (q + 1) + (xcd - r) * q) + off; }
        const int nig = WGM * nN, gid = wgid / nig, fm = gid * WGM, gsz = (nM - fm) < WGM ? (nM - fm) : WGM;
        u.pm = fm + ((wgid % nig) % gsz); u.pn = (wgid % nig) / gsz; return true;
    }
    __device__ __forceinline__ void a_ready(const Unit&) const {}
    __device__ __forceinline__ void done(const Unit&) const {}
};

__device__ __forceinline__ unsigned cvt_pk_bf16(float lo, float hi) { unsigned r; asm volatile("v_cvt_pk_bf16_f32 %0, %1, %2" : "=v"(r) : "v"(lo), "v"(hi)); return r; }
typedef float f32x2 __attribute__((ext_vector_type(2)));
__device__ __forceinline__ f32x2 gelu_pk(f32x2 v) {
    const f32x2 av = __builtin_elementwise_abs(v), d = av * 0.2316418882f + 1.0f;
    f32x2 t; t.x = __builtin_amdgcn_rcpf(d.x); t.y = __builtin_amdgcn_rcpf(d.y);
    f32x2 q = t * 0.5307027145f + (-0.7265760135f); q = q * t + 0.7107068705f; q = q * t + (-0.142248368f); q = q * t + 0.127414796f; q = q * t;
    const f32x2 s = (v * v) * (-0.72134752044f);
    f32x2 e; e.x = __builtin_amdgcn_exp2f(s.x); e.y = __builtin_amdgcn_exp2f(s.y);
    const f32x2 m = v * (q * e), r = v - m;
    f32x2 o; o.x = v.x < 0.f ? m.x : r.x; o.y = v.y < 0.f ? m.y : r.y; return o;
}

template <int ACT  > struct EpiBf16 {
    static constexpr bool PERM = true, AFTER_DRAIN = false; static_assert(ACT == 0 || ACT == 1, "EpiBf16: ACT is 0 (none) or 1 (gelu_pk)");
    bf16_t* O; int ldc; const float* bias; int split_cols; size_t split_stride; float scale0;
    __device__ __forceinline__ void operator()(const f32x4 (&acc)[2][2][4][2], const Unit& u, int wr, int wc, int fr, int fq) const {
        const int row0 = u.pm * BM + wr * 64 + fr; int colt = u.pn * BM; bf16_t* base = O;
        float sc = 1.f; if (split_cols) { const int t = colt / split_cols; base += (size_t)t * split_stride; colt -= t * split_cols; if (t == 0) sc = scale0; }
        const int col0 = colt + wc * 32 + 8 * fq, bcol0 = u.pn * BM + wc * 32 + 8 * fq;
        f32x4 bv[2][2];
#pragma unroll
        for (int bj = 0; bj < 2; ++bj)
#pragma unroll
            for (int n = 0; n < 2; ++n) bv[bj][n] = bias ? *(const f32x4*)(bias + bcol0 + bj * HALF + 4 * n) : (f32x4){0.f, 0.f, 0.f, 0.f};
#pragma unroll
        for (int ai = 0; ai < 2; ++ai)
#pragma unroll
            for (int m = 0; m < 4; ++m) { bf16_t* rowp = base + (size_t)(row0 + ai * HALF + m * 16) * ldc + col0;
#pragma unroll
                for (int bj = 0; bj < 2; ++bj) { f32x4 v0 = acc[ai][bj][m][0] + bv[bj][0], v1 = acc[ai][bj][m][1] + bv[bj][1];
                    if (ACT == 1) { f32x2 a = gelu_pk((f32x2){v0[0], v0[1]}), b = gelu_pk((f32x2){v0[2], v0[3]}), c = gelu_pk((f32x2){v1[0], v1[1]}), d = gelu_pk((f32x2){v1[2], v1[3]});
                        v0 = (f32x4){a.x, a.y, b.x, b.y}; v1 = (f32x4){c.x, c.y, d.x, d.y}; }
                    v0 = v0 * sc; v1 = v1 * sc; u32x4 w; w.x = cvt_pk_bf16(v0[0], v0[1]); w.y = cvt_pk_bf16(v0[2], v0[3]); w.z = cvt_pk_bf16(v1[0], v1[1]); w.w = cvt_pk_bf16(v1[2], v1[3]);
                    *(u32x4*)(rowp + bj * HALF) = w; } }
    }
};
__device__ __forceinline__ void row_factors(const float* rs, int row0, int fq, float (&rf)[2][4]) {
#pragma unroll
    for (int ai = 0; ai < 2; ++ai)
#pragma unroll
        for (int m = 0; m < 4; ++m) {
            const f32x4 p = *(const f32x4*)(rs + (size_t)(row0 + ai * HALF + m * 16) * 16 + 4 * fq);
            float s = (p[0] + p[1]) + (p[2] + p[3]);
            s += __shfl_xor(s, 16); s += __shfl_xor(s, 32);
            rf[ai][m] = rsqrtf(s * (1.0f / 1024.0f) + 1e-6f);
        }
}
__device__ __forceinline__ float sigmoid_fast(float v) { return __builtin_amdgcn_rcpf(1.0f + __builtin_amdgcn_exp2f(-1.44269504089f * v)); }
__device__ __forceinline__ float gelu_tanh(float v) { const float u = 0.7978845608f * (v + 0.044715f * v * v * v); return v * sigmoid_fast(2.0f * u); }

struct EpiSwiglu {
    static constexpr bool PERM = true, AFTER_DRAIN = false;
    bf16_t* O; int ldo; const float* rs; const float* sb; int nsb;
    __device__ __forceinline__ void operator()(const f32x4 (&acc)[2][2][4][2], const Unit& u, int wr, int wc, int fr, int fq) const {
        const int row0 = u.pm * BM + wr * 64 + fr, b = (u.pm * BM) >> 13;
        float rf[2][4]; row_factors(rs, row0, fq, rf);
        const float* sbp = sb + (size_t)b * nsb + u.pn * BM + wc * 32 + 8 * fq;
        f32x4 bg[2], bu[2];
#pragma unroll
        for (int n = 0; n < 2; ++n) { bg[n] = *(const f32x4*)(sbp + 4 * n); bu[n] = *(const f32x4*)(sbp + HALF + 4 * n); }
        const int col0 = u.pn * HALF + wc * 32 + 8 * fq;
#pragma unroll
        for (int ai = 0; ai < 2; ++ai)
#pragma unroll
            for (int m = 0; m < 4; ++m) {
                const float r = rf[ai][m]; float o[8];
#pragma unroll
                for (int n = 0; n < 2; ++n)
#pragma unroll
                    for (int j = 0; j < 4; ++j) { const float g = acc[ai][0][m][n][j] * r + bg[n][j], uu = acc[ai][1][m][n][j] * r + bu[n][j]; o[4 * n + j] = g * sigmoid_fast(g) * uu; }
                u32x4 w; w.x = cvt_pk_bf16(o[0], o[1]); w.y = cvt_pk_bf16(o[2], o[3]); w.z = cvt_pk_bf16(o[4], o[5]); w.w = cvt_pk_bf16(o[6], o[7]);
                *(u32x4*)(O + (size_t)(row0 + ai * HALF + m * 16) * ldo + col0) = w;
            }
    }
};
struct EpiProj {
    static constexpr bool PERM = true, AFTER_DRAIN = false;
    bf16_t* O; int ldo; const float* rs; const float* sb; int nsb; int gelu_from;
    __device__ __forceinline__ void operator()(const f32x4 (&acc)[2][2][4][2], const Unit& u, int wr, int wc, int fr, int fq) const {
        const int row0 = u.pm * BM + wr * 64 + fr, b = (u.pm * BM) >> 13;
        float rf[2][4]; row_factors(rs, row0, fq, rf);
        const int col0 = u.pn * BM + wc * 32 + 8 * fq;
        const float* sbp = sb + (size_t)b * nsb + col0;
        f32x4 bv[2][2];
#pragma unroll
        for (int bj = 0; bj < 2; ++bj)
#pragma unroll
            for (int n = 0; n < 2; ++n) bv[bj][n] = *(const f32x4*)(sbp + bj * HALF + 4 * n);
        const bool act = (u.pn * BM) >= gelu_from;
#pragma unroll
        for (int ai = 0; ai < 2; ++ai)
#pragma unroll
            for (int m = 0; m < 4; ++m) {
                const float r = rf[ai][m]; bf16_t* rowp = O + (size_t)(row0 + ai * HALF + m * 16) * ldo + col0;
#pragma unroll
                for (int bj = 0; bj < 2; ++bj) { float o[8];
#pragma unroll
                    for (int n = 0; n < 2; ++n)
#pragma unroll
                        for (int j = 0; j < 4; ++j) { const float v = acc[ai][bj][m][n][j] * r + bv[bj][n][j]; o[4 * n + j] = act ? gelu_tanh(v) : v; }
                    u32x4 w; w.x = cvt_pk_bf16(o[0], o[1]); w.y = cvt_pk_bf16(o[2], o[3]); w.z = cvt_pk_bf16(o[4], o[5]); w.w = cvt_pk_bf16(o[6], o[7]);
                    *(u32x4*)(rowp + bj * HALF) = w; }
            }
    }
};
template <bool LAST> struct EpiRes {
    static constexpr bool PERM = true, AFTER_DRAIN = false;
    const float* xold; float* xnew; bf16_t* xs; float* rs; const float* gate; const float* scale_next; const float* ng; float coef, pad_;
    __device__ __forceinline__ void operator()(const f32x4 (&acc)[2][2][4][2], const Unit& u, int wr, int wc, int fr, int fq) const {
        const int row0 = u.pm * BM + wr * 64 + fr, b = (u.pm * BM) >> 13;
        const int col0 = u.pn * BM + wc * 32 + 8 * fq;
        f32x4 gt[2][2], gs[2][2];
#pragma unroll
        for (int bj = 0; bj < 2; ++bj)
#pragma unroll
            for (int n = 0; n < 2; ++n) { const int c = col0 + bj * HALF + 4 * n;
                gt[bj][n] = *(const f32x4*)(gate + (size_t)b * 9216 + c) * coef;
                if (!LAST) gs[bj][n] = *(const f32x4*)(ng + c) * (*(const f32x4*)(scale_next + (size_t)b * 9216 + c) + 1.0f); }
#pragma unroll
        for (int ai = 0; ai < 2; ++ai)
#pragma unroll
            for (int m = 0; m < 4; ++m) {
                const size_t off = (size_t)(row0 + ai * HALF + m * 16) * 1024 + col0; float ss = 0.f;
#pragma unroll
                for (int bj = 0; bj < 2; ++bj) { f32x4 xn[2];
#pragma unroll
                    for (int n = 0; n < 2; ++n) { xn[n] = *(const f32x4*)(xold + off + bj * HALF + 4 * n) + gt[bj][n] * acc[ai][bj][m][n];
                        *(f32x4*)(xnew + off + bj * HALF + 4 * n) = xn[n]; }
                    if (!LAST) { ss += (xn[0][0] * xn[0][0] + xn[0][1] * xn[0][1]) + (xn[0][2] * xn[0][2] + xn[0][3] * xn[0][3]) + (xn[1][0] * xn[1][0] + xn[1][1] * xn[1][1]) + (xn[1][2] * xn[1][2] + xn[1][3] * xn[1][3]);
                        const f32x4 a = xn[0] * gs[bj][0], c = xn[1] * gs[bj][1];
                        u32x4 w; w.x = cvt_pk_bf16(a[0], a[1]); w.y = cvt_pk_bf16(a[2], a[3]); w.z = cvt_pk_bf16(c[0], c[1]); w.w = cvt_pk_bf16(c[2], c[3]);
                        *(u32x4*)(xs + off + bj * HALF) = w; } }
                if (!LAST) { ss += __shfl_xor(ss, 16); ss += __shfl_xor(ss, 32);
                    if (fq == 0) rs[(size_t)(row0 + ai * HALF + m * 16) * 16 + u.pn * 4 + wc] = ss; }
            }
    }
};

template <class Epi, class Sched, bool ALIGN_EPI = false, bool SP2 = false>
__device__ __forceinline__ void gemm_phase(PG8_LAS unsigned char* lds, const Gemm g, const Sched S, const Epi E) {
    const int tid = threadIdx.x, wid = __builtin_amdgcn_readfirstlane(tid >> 6), lane = tid & 63, wr = wid >> 2, wc = wid & 3, fr = lane & 15, fq = lane >> 4;
    const int K = g.K, nt = K / BK;
    unsigned voffA[2], voffB[2];
#pragma unroll
    for (int i = 0; i < 2; ++i) { int R, C; stage_rc(tid * 16 + i * 8192, R, C); const int Rb = Epi::PERM ? ((R & ~31) + perm32(R & 31)) : R;
        voffA[i] = (unsigned)(R * K + C) * 2u; voffB[i] = (unsigned)(Rb * K + C) * 2u; }
    const size_t kstep = (size_t)(BK * 2);
    const size_t hstep = (size_t)HALF * K * 2;
    const size_t tstep = 2 * hstep;
    const unsigned ldsw = (unsigned)wid * 1024u;
    const int aoff = lds_byte(wr * 64 + fr, fq * 8), boff = lds_byte(wc * 32 + fr, fq * 8);
#define PG8_SA(b, h) (((b) * 2 + (h)) * HTB)
#define PG8_SB(b, h) ((4 + (b) * 2 + (h)) * HTB)
#define PG8_STAGE(bufoff, gbase, voff) do { _Pragma("unroll") for (int _i = 0; _i < 2; ++_i) \
        __builtin_amdgcn_global_load_lds((const unsigned*)((const char*)(gbase) + (voff)[_i]), (PG8_LAS unsigned*)(lds + (bufoff) + ldsw + _i * 8192), 16, 0, 0); } while (0)
#define PG8_LDA(dst, b, h) do { _Pragma("unroll") for (int m = 0; m < 4; ++m) _Pragma("unroll") for (int k = 0; k < 2; ++k) dst[m][k] = *(const PG8_LAS bf16x8*)(lds + PG8_SA(b, h) + aoff + m * 2048 + k * 1024); } while (0)
#define PG8_LDB(dst, b, h) do { _Pragma("unroll") for (int n = 0; n < 2; ++n) _Pragma("unroll") for (int k = 0; k < 2; ++k) dst[n][k] = *(const PG8_LAS bf16x8*)(lds + PG8_SB(b, h) + boff + n * 2048 + k * 1024); } while (0)
#define PG8_MMA(ai, bj, At, Bt) do { __builtin_amdgcn_s_setprio(1); _Pragma("unroll") for (int m = 0; m < 4; ++m) _Pragma("unroll") for (int n = 0; n < 2; ++n) _Pragma("unroll") for (int k = 0; k < 2; ++k) \
        acc[ai][bj][m][n] = __builtin_amdgcn_mfma_f32_16x16x32_bf16(Bt[n][k], At[m][k], acc[ai][bj][m][n], 0, 0, 0); __builtin_amdgcn_s_setprio(0); } while (0)
#define PG8_WAIT_V(n) asm volatile("s_waitcnt vmcnt(" #n ")" ::: "memory")
#define PG8_WAIT_L(n) asm volatile("s_waitcnt lgkmcnt(" #n ")" ::: "memory")
#define PG8_BAR __builtin_amdgcn_s_barrier()
#define PG8_SCHED __builtin_amdgcn_sched_barrier(0)
    Unit cur, nxt; int ui = 0;
    if (!S.next(0, cur)) return;
    f32x4 acc[2][2][4][2];
#pragma unroll
    for (int a = 0; a < 2; ++a)
#pragma unroll
        for (int b = 0; b < 2; ++b)
#pragma unroll
            for (int m = 0; m < 4; ++m)
#pragma unroll
                for (int n = 0; n < 2; ++n) acc[a][b][m][n] = (f32x4){0.f, 0.f, 0.f, 0.f};
    bf16x8 At[4][2], B0[2][2], B1[2][2];
    const char* cA = (const char*)g.A + (size_t)cur.pm * tstep; const char* cB = (const char*)g.Bt + (size_t)cur.pn * tstep;
    S.a_ready(cur);
    if constexpr (SP2) {
        PG8_STAGE(PG8_SB(0, 0), cB, voffB); PG8_STAGE(PG8_SB(0, 1), cB + hstep, voffB); PG8_STAGE(PG8_SA(0, 0), cA, voffA); PG8_STAGE(PG8_SA(0, 1), cA + hstep, voffA);
        if (wr == 1) PG8_BAR;
        PG8_WAIT_V(2); PG8_BAR;
        PG8_STAGE(PG8_SB(1, 0), cB + kstep, voffB); PG8_STAGE(PG8_SA(1, 0), cA + kstep, voffA); PG8_STAGE(PG8_SB(1, 1), cB + hstep + kstep, voffB);
        PG8_WAIT_V(6); PG8_BAR;
    } else {
        PG8_STAGE(PG8_SB(0, 0), cB, voffB); PG8_STAGE(PG8_SA(0, 0), cA, voffA); PG8_STAGE(PG8_SB(0, 1), cB + hstep, voffB); PG8_STAGE(PG8_SA(0, 1), cA + hstep, voffA);
        if (wr == 1) PG8_BAR;
        PG8_WAIT_V(4); PG8_BAR;
        PG8_STAGE(PG8_SB(1, 0), cB + kstep, voffB); PG8_STAGE(PG8_SA(1, 0), cA + kstep, voffA); PG8_STAGE(PG8_SB(1, 1), cB + hstep + kstep, voffB);
        PG8_WAIT_V(6); PG8_BAR;
    }
    for (;;) {
        const bool has_next = S.next(ui + 1, nxt);
        const char* nA = has_next ? (const char*)g.A + (size_t)nxt.pm * tstep : cA; const char* nB = has_next ? (const char*)g.Bt + (size_t)nxt.pn * tstep : cB;
        for (int t = 0; t < nt; t += 2) {
            const bool last = (t == nt - 2);
            const char* a1 = cA + (size_t)(t + 1) * kstep;
            const char* a2 = last ? nA : cA + (size_t)(t + 2) * kstep; const char* b2 = last ? nB : cB + (size_t)(t + 2) * kstep;
            const char* a3 = a2 + kstep; const char* b3 = b2 + kstep;
            if (last && has_next) S.a_ready(nxt);
            if constexpr (SP2) {
            PG8_LDB(B0, 0, 0); PG8_LDB(B1, 0, 1); PG8_SCHED; PG8_LDA(At, 0, 0); PG8_STAGE(PG8_SA(1, 1), a1 + hstep, voffA);
            PG8_WAIT_V(8); PG8_WAIT_L(0); PG8_BAR; PG8_MMA(0, 0, At, B0); PG8_MMA(0, 1, At, B1); PG8_BAR; PG8_SCHED;
            PG8_LDA(At, 0, 1); PG8_STAGE(PG8_SB(0, 0), b2, voffB); PG8_STAGE(PG8_SB(0, 1), b2 + hstep, voffB); PG8_STAGE(PG8_SA(0, 0), a2, voffA);
            PG8_WAIT_V(8); PG8_WAIT_L(0); PG8_BAR; PG8_MMA(1, 0, At, B0); PG8_MMA(1, 1, At, B1); PG8_BAR; PG8_SCHED;
            PG8_LDB(B0, 1, 0); PG8_LDB(B1, 1, 1); PG8_SCHED; PG8_LDA(At, 1, 0); PG8_STAGE(PG8_SA(0, 1), a2 + hstep, voffA);
            PG8_WAIT_V(8); PG8_WAIT_L(0); PG8_BAR; PG8_MMA(0, 0, At, B0); PG8_MMA(0, 1, At, B1); PG8_BAR; PG8_SCHED;
            PG8_LDA(At, 1, 1); PG8_STAGE(PG8_SB(1, 0), b3, voffB); PG8_STAGE(PG8_SB(1, 1), b3 + hstep, voffB); PG8_STAGE(PG8_SA(1, 0), a3, voffA);
            PG8_WAIT_V(8); PG8_WAIT_L(0); PG8_BAR; PG8_MMA(1, 0, At, B0); PG8_MMA(1, 1, At, B1); PG8_BAR; PG8_SCHED;
            } else {
            PG8_LDB(B0, 0, 0); PG8_SCHED; PG8_LDA(At, 0, 0); PG8_STAGE(PG8_SA(1, 1), a1 + hstep, voffA);
            PG8_WAIT_L(8); PG8_BAR; PG8_WAIT_L(0); PG8_MMA(0, 0, At, B0); PG8_BAR; PG8_SCHED;
            PG8_LDB(B1, 0, 1); PG8_STAGE(PG8_SB(0, 0), b2, voffB);
            PG8_BAR; PG8_WAIT_L(0); PG8_MMA(0, 1, At, B1); PG8_BAR;
            PG8_LDA(At, 0, 1); PG8_STAGE(PG8_SA(0, 0), a2, voffA);
            PG8_BAR; PG8_WAIT_L(0); PG8_MMA(1, 0, At, B0); PG8_BAR; PG8_SCHED;
            PG8_STAGE(PG8_SB(0, 1), b2 + hstep, voffB);
            PG8_WAIT_V(6); PG8_BAR; PG8_MMA(1, 1, At, B1); PG8_BAR;
            PG8_LDB(B0, 1, 0); PG8_SCHED; PG8_LDA(At, 1, 0); PG8_STAGE(PG8_SA(0, 1), a2 + hstep, voffA);
            PG8_WAIT_L(8); PG8_BAR; PG8_WAIT_L(0); PG8_MMA(0, 0, At, B0); PG8_BAR; PG8_SCHED;
            PG8_LDB(B1, 1, 1); PG8_STAGE(PG8_SB(1, 0), b3, voffB);
            PG8_BAR; PG8_WAIT_L(0); PG8_MMA(0, 1, At, B1); PG8_BAR;
            PG8_LDA(At, 1, 1); PG8_STAGE(PG8_SA(1, 0), a3, voffA);
            PG8_BAR; PG8_WAIT_L(0); PG8_MMA(1, 0, At, B0); PG8_BAR; PG8_SCHED;
            PG8_STAGE(PG8_SB(1, 1), b3 + hstep, voffB);
            PG8_WAIT_V(6); PG8_BAR; PG8_MMA(1, 1, At, B1); PG8_BAR;
            }
        }
        if constexpr (ALIGN_EPI) { if (wr == 0) PG8_BAR; }
        if constexpr (!Epi::AFTER_DRAIN) { E(acc, cur, wr, wc, fr, fq); S.done(cur); }
        if (!has_next) break;
#pragma unroll
        for (int a = 0; a < 2; ++a)
#pragma unroll
            for (int b = 0; b < 2; ++b)
#pragma unroll
                for (int m = 0; m < 4; ++m)
#pragma unroll
                    for (int n = 0; n < 2; ++n) acc[a][b][m][n] = (f32x4){0.f, 0.f, 0.f, 0.f};
        cur = nxt; cA = nA; cB = nB; ++ui;
        if constexpr (ALIGN_EPI) { if (wr == 1) PG8_BAR; }
    }
    PG8_WAIT_V(0);
    if constexpr (!ALIGN_EPI) { if (wr == 0) PG8_BAR; }
    PG8_BAR;
    if constexpr (Epi::AFTER_DRAIN) { E.fused(acc, cur, wr, wc, fr, fq, lds, wid, lane); S.done(cur); }
#undef PG8_SA
#undef PG8_SB
#undef PG8_STAGE
#undef PG8_LDA
#undef PG8_LDB
#undef PG8_MMA
#undef PG8_WAIT_V
#undef PG8_WAIT_L
#undef PG8_BAR
#undef PG8_SCHED
}
}
#ifndef MK_N_LAUNCHES
#define MK_N_LAUNCHES 1
#endif
constexpr int NWAVES = 8, NTHREADS = 512;
constexpr int BATCH = 4, SEQ = 8192, D = 1024, M = BATCH * SEQ, FF = 2816, NFF = 2 * FF, NMIX = 1536, NMOD = 9216, CHUNK = 128, NCHUNK = M / CHUNK;
constexpr int NPHASE = 10;
constexpr size_t MiB = 1u << 20;
constexpr size_t WS_MOD = 0;
constexpr size_t WS_SB1 = 1 * MiB, WS_SB2 = WS_SB1 + 128 * 1024, WS_SB3 = WS_SB1 + 256 * 1024;
constexpr size_t WS_RS0 = 2 * MiB, WS_RS1 = 4 * MiB, WS_RS2 = 6 * MiB;
constexpr size_t WS_W1A = 8 * MiB, WS_W2A = 20 * MiB, WS_WMI = 26 * MiB, WS_WMO = 30 * MiB, WS_W1B = 32 * MiB, WS_W2B = 44 * MiB, WS_WPT = 50 * MiB, WS_WSP = 51 * MiB;
constexpr size_t WS_XS = 64 * MiB;
constexpr size_t WS_X1 = 128 * MiB;
constexpr size_t WS_ACT = 256 * MiB;
constexpr size_t WS_PROJ = 256 * MiB, WS_YCAT = 352 * MiB;
constexpr size_t WS_END = 432 * MiB;
constexpr int LDS_BYTES = 147456;

#define GAS __attribute__((address_space(1)))
#define LAS __attribute__((address_space(3)))
typedef unsigned short bf16;
typedef unsigned v4u __attribute__((ext_vector_type(4)));
typedef unsigned v2u __attribute__((ext_vector_type(2)));
typedef float f32x4 __attribute__((ext_vector_type(4)));
typedef float f32x2 __attribute__((ext_vector_type(2)));
typedef short bf16x8 __attribute__((ext_vector_type(8)));
#define LDS_WAIT() asm volatile("s_waitcnt lgkmcnt(0)" ::: "memory")
__device__ __forceinline__ unsigned f2bf(float f) { unsigned u = __builtin_bit_cast(unsigned, f); return (u + 0x7fffu + ((u >> 16) & 1u)) >> 16; }
__device__ __forceinline__ unsigned pk2(float lo, float hi) { return f2bf(lo) | (f2bf(hi) << 16); }
__device__ __forceinline__ float bflo(unsigned w) { return __uint_as_float(w << 16); }
__device__ __forceinline__ float bfhi(unsigned w) { return __uint_as_float(w & 0xffff0000u); }
__device__ __forceinline__ float wave_sum(float v) {
#pragma unroll
    for (int o = 1; o < 64; o <<= 1) v += __shfl_xor(v, o);
    return v;
}

struct Ctx {
    LAS unsigned char* lds; int tid, lane, wave, bid, G;
    const float* in[20]; float* out; unsigned char* ws;
};

__device__ __forceinline__ void p0_transpose_item(const float* W, int K, int N, bf16* WT, int mode, LAS float* scr, int item, int lane) {
    const int nblk = N / 32, kb = item / nblk, nb = item % nblk, k0 = 64 * kb, n0 = 32 * nb;
    int r0 = n0;
    if (mode == 1) { r0 = (n0 < FF) ? (256 * (n0 >> 7) + (n0 & 127)) : (256 * ((n0 - FF) >> 7) + 128 + ((n0 - FF) & 127)); }
#pragma unroll 8
    for (int i = 0; i < 32; ++i) { const int kk = 2 * i + (lane >> 5); scr[kk * 33 + (lane & 31)] = W[(size_t)(k0 + kk) * N + n0 + (lane & 31)]; }
    LDS_WAIT(); asm volatile("" ::: "memory");
    const int c = lane & 7;
#pragma unroll
    for (int j = 0; j < 4; ++j) { const int n = (lane >> 3) + 8 * j; const LAS float* s = scr + (8 * c) * 33 + n;
        v4u o; o.x = pk2(s[0 * 33], s[1 * 33]); o.y = pk2(s[2 * 33], s[3 * 33]); o.z = pk2(s[4 * 33], s[5 * 33]); o.w = pk2(s[6 * 33], s[7 * 33]);
        *(GAS v4u*)(WT + (size_t)(r0 + n) * K + k0 + 8 * c) = o; }
    LDS_WAIT(); asm volatile("" ::: "memory");
}
__device__ __forceinline__ void p0_mod_item(Ctx& F, int item) {
    const float* c = F.in[1]; const float* wa = F.in[2]; const float* ba = F.in[3]; float* mod = (float*)(F.ws + WS_MOD);
    const int j0 = item * 128 + 2 * F.lane, kbeg = F.wave * 128;
    float a[4][2] = {};
#pragma unroll 8
    for (int k = 0; k < 128; ++k) {
        const f32x2 w = *(const f32x2*)(wa + (size_t)(kbeg + k) * NMOD + j0);
#pragma unroll
        for (int b = 0; b < 4; ++b) { const float cv = c[b * D + kbeg + k]; const float s = cv / (1.0f + __expf(-cv)); a[b][0] += s * w.x; a[b][1] += s * w.y; }
    }
    LAS float* red = (LAS float*)F.lds;
#pragma unroll
    for (int b = 0; b < 4; ++b) { red[(F.wave * 4 + b) * 128 + 2 * F.lane] = a[b][0]; red[(F.wave * 4 + b) * 128 + 2 * F.lane + 1] = a[b][1]; }
    __syncthreads();
    { const int b = F.tid >> 7, col = F.tid & 127; float s = ba[item * 128 + col];
#pragma unroll
      for (int w = 0; w < 8; ++w) s += red[(w * 4 + b) * 128 + col];
      mod[b * NMOD + item * 128 + col] = s; }
    __syncthreads();
}
__device__ __forceinline__ void phase0(Ctx& F) {
    for (int it = F.bid; it < NMOD / 128; it += F.G) p0_mod_item(F, it);
    LAS float* scr = (LAS float*)(F.lds + F.wave * 16384);
    const int gw = F.bid * NWAVES + F.wave, NGW = F.G * NWAVES;
    constexpr int I_1 = (D / 64) * (NFF / 32), I_2 = (FF / 64) * (D / 32), I_MI = (D / 64) * (NMIX / 32), I_MO = (D / 64) * (D / 32), I_P = 4 * 2 * 4;
    constexpr int NITEMS = 2 * I_1 + 2 * I_2 + I_MI + I_MO + I_P;
    for (int it = gw; it < NITEMS; it += NGW) {
        int r = it;
        if (r < I_1) { p0_transpose_item(F.in[5], D, NFF, (bf16*)(F.ws + WS_W1A), 1, scr, r, F.lane); continue; } r -= I_1;
        if (r < I_1) { p0_transpose_item(F.in[17], D, NFF, (bf16*)(F.ws + WS_W1B), 1, scr, r, F.lane); continue; } r -= I_1;
        if (r < I_2) { p0_transpose_item(F.in[6], FF, D, (bf16*)(F.ws + WS_W2A), 0, scr, r, F.lane); continue; } r -= I_2;
        if (r < I_2) { p0_transpose_item(F.in[18], FF, D, (bf16*)(F.ws + WS_W2B), 0, scr, r, F.lane); continue; } r -= I_2;
        if (r < I_MI) { p0_transpose_item(F.in[8], D, NMIX, (bf16*)(F.ws + WS_WMI), 0, scr, r, F.lane); continue; } r -= I_MI;
        if (r < I_MO) { p0_transpose_item(F.in[15], D, D, (bf16*)(F.ws + WS_WMO), 0, scr, r, F.lane); continue; } r -= I_MO;
        { const int g = r >> 3; p0_transpose_item(F.in[9] + (size_t)g * 128 * 128, 128, 128, (bf16*)(F.ws + WS_WPT) + (size_t)g * 128 * 128, 0, scr, r & 7, F.lane); }
    }
    { const float* wsp = F.in[13]; bf16* o = (bf16*)(F.ws + WS_WSP);
      for (int i = (F.bid * NTHREADS + F.tid) * 4; i < 8 * 128 * 128; i += F.G * NTHREADS * 4) {
          const f32x4 v = *(const f32x4*)(wsp + i); const int t = (i >> 7) & 127, s = i & 127;
          v2u w; w.x = pk2(s <= t ? v[0] : 0.f, s + 1 <= t ? v[1] : 0.f); w.y = pk2(s + 2 <= t ? v[2] : 0.f, s + 3 <= t ? v[3] : 0.f);
          *(GAS v2u*)(o + i) = w; } }
}
__device__ __forceinline__ void phase1(Ctx& F) {
    const float* mod = (const float*)(F.ws + WS_MOD);
    const int gw = F.bid * NWAVES + F.wave, NGW = F.G * NWAVES;
    const float* x = F.in[0]; const float* ng = F.in[4]; bf16* xs = (bf16*)(F.ws + WS_XS); float* rs0 = (float*)(F.ws + WS_RS0);
    for (int row = gw; row < M; row += NGW) {
        const int b = row >> 13; const GAS f32x4* xr = (const GAS f32x4*)(x + (size_t)row * D) + F.lane;
        GAS unsigned long long* o8 = (GAS unsigned long long*)(xs + (size_t)row * D) + F.lane; float ss = 0.f;
#pragma unroll
        for (int j = 0; j < 4; ++j) { const f32x4 v = xr[64 * j]; const int col = 4 * F.lane + 256 * j;
            const f32x4 gs = *(const f32x4*)(ng + col) * (*(const f32x4*)(mod + b * NMOD + 1024 + col) + 1.0f);
            ss += (v.x * v.x + v.y * v.y) + (v.z * v.z + v.w * v.w); const f32x4 h = v * gs;
            o8[64 * j] = (unsigned long long)pk2(h.x, h.y) | ((unsigned long long)pk2(h.z, h.w) << 32); }
        ss = wave_sum(ss);
        if (F.lane < 16) rs0[(size_t)row * 16 + F.lane] = ss * (1.0f / 16.0f);
    }
    for (int n = gw; n < NFF + NMIX + NFF; n += NGW) {
        const bf16* wrow; const float* sh; float* dst; int nn, ld;
        if (n < NFF) { nn = n; wrow = (const bf16*)(F.ws + WS_W1A); sh = mod + 0; dst = (float*)(F.ws + WS_SB1); ld = NFF; }
        else if (n < NFF + NMIX) { nn = n - NFF; wrow = (const bf16*)(F.ws + WS_WMI); sh = mod + 3072; dst = (float*)(F.ws + WS_SB2); ld = NMIX; }
        else { nn = n - NFF - NMIX; wrow = (const bf16*)(F.ws + WS_W1B); sh = mod + 6144; dst = (float*)(F.ws + WS_SB3); ld = NFF; }
        wrow += (size_t)nn * D; float a[4] = {0.f, 0.f, 0.f, 0.f};
#pragma unroll
        for (int h = 0; h < 2; ++h) { const int k0 = h * 512 + 8 * F.lane; const v4u w = *(const GAS v4u*)(wrow + k0);
            const float wf[8] = {bflo(w.x), bfhi(w.x), bflo(w.y), bfhi(w.y), bflo(w.z), bfhi(w.z), bflo(w.w), bfhi(w.w)};
#pragma unroll
            for (int b = 0; b < 4; ++b) { const f32x4 s0 = *(const f32x4*)(sh + b * NMOD + k0), s1 = *(const f32x4*)(sh + b * NMOD + k0 + 4);
                a[b] += (wf[0] * s0.x + wf[1] * s0.y) + (wf[2] * s0.z + wf[3] * s0.w) + (wf[4] * s1.x + wf[5] * s1.y) + (wf[6] * s1.z + wf[7] * s1.w); } }
#pragma unroll
        for (int b = 0; b < 4; ++b) a[b] = wave_sum(a[b]);
        if (F.lane < 4) dst[F.lane * ld + nn] = (F.lane == 0) ? a[0] : (F.lane == 1) ? a[1] : (F.lane == 2) ? a[2] : a[3];
    }
}
__device__ __forceinline__ void gmlp_unit(Ctx& F, int ch) {
    const bf16* proj = (const bf16*)(F.ws + WS_PROJ) + (size_t)ch * CHUNK * NMIX; bf16* ycat = (bf16*)(F.ws + WS_YCAT) + (size_t)ch * CHUNK * D;
    int lane_ = F.lane; asm volatile("" : "+v"(lane_));
    const int lane = lane_, w = F.wave, fr = lane & 15, fq = lane >> 4;
    {
        const int c0 = 8 * lane; float g8[8], b8[8];
        { const f32x4 a = *(const f32x4*)(F.in[11] + c0), b = *(const f32x4*)(F.in[11] + c0 + 4), c = *(const f32x4*)(F.in[12] + c0), d = *(const f32x4*)(F.in[12] + c0 + 4);
#pragma unroll
          for (int j = 0; j < 4; ++j) { g8[j] = a[j]; g8[4 + j] = b[j]; b8[j] = c[j]; b8[4 + j] = d[j]; } }
#pragma unroll
        for (int gi = 0; gi < 2; ++gi) {
            float vals[8][8];
#pragma unroll
            for (int i = 0; i < 8; ++i) {
                const v4u raw = *(const GAS v4u*)(proj + (size_t)(16 * w + 8 * gi + i) * NMIX + 1024 + c0);
                float xv[8] = {bflo(raw.x), bfhi(raw.x), bflo(raw.y), bfhi(raw.y), bflo(raw.z), bfhi(raw.z), bflo(raw.w), bfhi(raw.w)};
                float s = ((xv[0] + xv[1]) + (xv[2] + xv[3])) + ((xv[4] + xv[5]) + (xv[6] + xv[7]));
                const float mean = wave_sum(s) * (1.0f / 512.0f); float q = 0.f;
#pragma unroll
                for (int j = 0; j < 8; ++j) { xv[j] -= mean; q += xv[j] * xv[j]; }
                const float rstd = rsqrtf(wave_sum(q) * (1.0f / 512.0f) + 1e-6f);
#pragma unroll
                for (int j = 0; j < 8; ++j) vals[i][j] = xv[j] * rstd * g8[j] + b8[j];
            }
            const int G = 2 * w + gi;
#pragma unroll
            for (int j = 0; j < 8; ++j) { const int c = c0 + j, sig = (c ^ (c >> 3)) & 15; v4u pkv;
                pkv.x = pk2(vals[0][j], vals[1][j]); pkv.y = pk2(vals[2][j], vals[3][j]); pkv.z = pk2(vals[4][j], vals[5][j]); pkv.w = pk2(vals[6][j], vals[7][j]);
                *(LAS v4u*)(F.lds + c * 256 + ((G ^ sig) << 4)) = pkv; }
            asm volatile("" ::: "memory"); __builtin_amdgcn_sched_barrier(0);
        }
    }
    __syncthreads();
    {
        const int h = w; const bf16* wsp = (const bf16*)(F.ws + WS_WSP) + (size_t)h * 128 * 128;
        const float* bsp = F.in[14] + h * 128;
#pragma unroll
        for (int mh = 0; mh < 2; ++mh) {
            f32x4 acc[4][4];
#pragma unroll
            for (int m = 0; m < 4; ++m)
#pragma unroll
                for (int n = 0; n < 4; ++n) acc[m][n] = (f32x4){0.f, 0.f, 0.f, 0.f};
#pragma unroll
            for (int kk = 0; kk < 4; ++kk) if (kk * 32 <= (mh * 4 + 3) * 16 + 15) {
                bf16x8 vb[4];
#pragma unroll
                for (int n = 0; n < 4; ++n) { const int c = h * 64 + n * 16 + fr, sig = (c ^ (c >> 3)) & 15, G = kk * 4 + fq; vb[n] = *(const LAS bf16x8*)(F.lds + c * 256 + ((G ^ sig) << 4)); }
#pragma unroll
                for (int mm = 0; mm < 4; ++mm) { const int m = mh * 4 + mm; if (kk * 32 <= m * 16 + 15) {
                    const bf16x8 wa = *(const GAS bf16x8*)(wsp + (size_t)(m * 16 + fr) * 128 + kk * 32 + fq * 8);
#pragma unroll
                    for (int n = 0; n < 4; ++n) acc[mm][n] = __builtin_amdgcn_mfma_f32_16x16x32_bf16(vb[n], wa, acc[mm][n], 0, 0, 0);
                } }
            }
#pragma unroll
            for (int mm = 0; mm < 4; ++mm) { const int t = (mh * 4 + mm) * 16 + fr; const float bt = bsp[t];
#pragma unroll
                for (int n = 0; n < 4; ++n) { const int c = 512 + h * 64 + n * 16 + 4 * fq;
                    const v2u ur = *(const GAS v2u*)(proj + (size_t)t * NMIX + c);
                    const f32x4 sv = acc[mm][n] + bt; v2u o; o.x = pk2(bflo(ur.x) * sv[0], bfhi(ur.x) * sv[1]); o.y = pk2(bflo(ur.y) * sv[2], bfhi(ur.y) * sv[3]);
                    *(GAS v2u*)(ycat + (size_t)t * D + c) = o; } }
            asm volatile("" ::: "memory"); __builtin_amdgcn_sched_barrier(0);
        }
    }
    __syncthreads();
}
template <int W> __device__ __forceinline__ void pool_stage1(const bf16* proj, LAS unsigned char* lds, int p0, int g, int hf, int lane) {
    const int cl = lane & 15, rq = lane >> 4, t0 = hf * 64 + rq * 16;
    const bf16* base = proj + g * 128 + cl * 8;
    float a[8] = {0.f, 0.f, 0.f, 0.f, 0.f, 0.f, 0.f, 0.f};
#define POOL_UNPK(xv, q) const float xv[8] = {bflo(q.x), bfhi(q.x), bflo(q.y), bfhi(q.y), bflo(q.z), bfhi(q.z), bflo(q.w), bfhi(q.w)}
#define POOL_LD(dst, t) v4u dst = *(const GAS v4u*)(base + (ptrdiff_t)((t) < -p0 ? -p0 : (t)) * NMIX); if (p0 + (t) < 0) dst = (v4u){0u, 0u, 0u, 0u}
#pragma unroll
    for (int r = 0; r < W - 1; ++r) { POOL_LD(q, t0 - (W - 1) + r); POOL_UNPK(xv, q);
#pragma unroll
        for (int j = 0; j < 8; ++j) a[j] += xv[j]; }
    asm volatile("" ::: "memory"); __builtin_amdgcn_sched_barrier(0);
#pragma unroll
    for (int i0 = 0; i0 < 16; i0 += 4) {
#pragma unroll
        for (int ii = 0; ii < 4; ++ii) { const int i = i0 + ii, t = t0 + i, pos = p0 + t; POOL_LD(qn, t); POOL_LD(qo, t - (W - 1)); POOL_UNPK(xv, qn); POOL_UNPK(xo, qo);
            const int cnt = (pos + 1 < W) ? pos + 1 : W; const float inv = 1.0f / (float)cnt; float o[8];
#pragma unroll
            for (int j = 0; j < 8; ++j) { a[j] += xv[j]; o[j] = a[j] * inv - xv[j]; a[j] -= xo[j]; }
            v4u pkv; pkv.x = pk2(o[0], o[1]); pkv.y = pk2(o[2], o[3]); pkv.z = pk2(o[4], o[5]); pkv.w = pk2(o[6], o[7]);
            *(LAS v4u*)(lds + g * 32768 + t * 256 + ((cl ^ (t & 15)) << 4)) = pkv; }
        asm volatile("" ::: "memory"); __builtin_amdgcn_sched_barrier(0);
    }
#undef POOL_LD
#undef POOL_UNPK
}
__device__ __forceinline__ void pool_unit(Ctx& F, int ch) {
    const bf16* proj = (const bf16*)(F.ws + WS_PROJ) + (size_t)ch * CHUNK * NMIX; bf16* ycat = (bf16*)(F.ws + WS_YCAT) + (size_t)ch * CHUNK * D;
    int lane_ = F.lane; asm volatile("" : "+v"(lane_));
    const int lane = lane_, w = F.wave, fr = lane & 15, fq = lane >> 4, g = w >> 1, hf = w & 1, p0 = (ch * CHUNK) & (SEQ - 1);
#if !defined(DBG_POOL) || DBG_POOL == 1
    if (g == 0) pool_stage1<2>(proj, F.lds, p0, 0, hf, lane);
    else if (g == 1) pool_stage1<4>(proj, F.lds, p0, 1, hf, lane);
    else if (g == 2) pool_stage1<8>(proj, F.lds, p0, 2, hf, lane);
    else pool_stage1<16>(proj, F.lds, p0, 3, hf, lane);
#endif
    __syncthreads();
#if !defined(DBG_POOL) || DBG_POOL == 2
    {
        const int dh = hf; const bf16* wpt = (const bf16*)(F.ws + WS_WPT) + (size_t)g * 128 * 128;
        const float* psc = F.in[10] + g * 128 + dh * 64;
#pragma unroll
        for (int mh = 0; mh < 2; ++mh) {
            f32x4 acc[4][4];
#pragma unroll
            for (int m = 0; m < 4; ++m)
#pragma unroll
                for (int n = 0; n < 4; ++n) acc[m][n] = (f32x4){0.f, 0.f, 0.f, 0.f};
#pragma unroll
            for (int kk = 0; kk < 4; ++kk) {
                bf16x8 wb[4];
#pragma unroll
                for (int n = 0; n < 4; ++n) wb[n] = *(const GAS bf16x8*)(wpt + (size_t)(dh * 64 + n * 16 + fr) * 128 + kk * 32 + fq * 8);
#pragma unroll
                for (int mm = 0; mm < 4; ++mm) { const int t = (mh * 4 + mm) * 16 + fr, G = kk * 4 + fq;
                    const bf16x8 pa = *(const LAS bf16x8*)(F.lds + g * 32768 + t * 256 + ((G ^ (t & 15)) << 4));
#pragma unroll
                    for (int n = 0; n < 4; ++n) acc[mm][n] = __builtin_amdgcn_mfma_f32_16x16x32_bf16(wb[n], pa, acc[mm][n], 0, 0, 0); }
            }
#pragma unroll
            for (int n = 0; n < 4; ++n) { const f32x4 sc = *(const f32x4*)(psc + n * 16 + 4 * fq);
#pragma unroll
                for (int mm = 0; mm < 4; ++mm) { const int t = (mh * 4 + mm) * 16 + fr; const f32x4 v = acc[mm][n] * sc; v2u o; o.x = pk2(v[0], v[1]); o.y = pk2(v[2], v[3]);
                    *(GAS v2u*)(ycat + (size_t)t * D + g * 128 + dh * 64 + n * 16 + 4 * fq) = o; } }
            asm volatile("" ::: "memory"); __builtin_amdgcn_sched_barrier(0);
        }
    }
#endif
    __syncthreads();
}
__device__ __forceinline__ void phase5(Ctx& F) {
#if !defined(DBG_P5) || DBG_P5 == 1
    for (int u = F.bid; u < NCHUNK; u += F.G) gmlp_unit(F, u);
#endif
#if !defined(DBG_P5) || DBG_P5 == 2
    for (int u = F.bid; u < NCHUNK; u += F.G) pool_unit(F, u);
#endif
}
__device__ __forceinline__ void phase9(Ctx& F) {
    const int gw = F.bid * NWAVES + F.wave, NGW = F.G * NWAVES; const float* ng = F.in[19];
    for (int row = gw; row < M; row += NGW) {
        GAS f32x4* xr = (GAS f32x4*)(F.out + (size_t)row * D) + F.lane; f32x4 v[4]; float ss = 0.f;
#pragma unroll
        for (int j = 0; j < 4; ++j) { v[j] = xr[64 * j]; ss += (v[j].x * v[j].x + v[j].y * v[j].y) + (v[j].z * v[j].z + v[j].w * v[j].w); }
        const float r = rsqrtf(wave_sum(ss) * (1.0f / D) + 1e-6f);
#pragma unroll
        for (int j = 0; j < 4; ++j) xr[64 * j] = v[j] * r * *(const f32x4*)(ng + 4 * F.lane + 256 * j);
    }
}
struct Args { const float* in[20]; float* out; unsigned char* ws; int ph_lo, ph_hi; };
__global__ void __launch_bounds__(NTHREADS, 2) mk_fwd(Args args) {
    extern __shared__ __attribute__((aligned(16))) unsigned char lds_raw[];
    cg::grid_group grid = cg::this_grid();
    Ctx F;
    F.lds = (LAS unsigned char*)lds_raw; F.tid = threadIdx.x; F.lane = F.tid & 63; F.wave = __builtin_amdgcn_readfirstlane(F.tid >> 6); F.bid = blockIdx.x; F.G = gridDim.x;
#pragma unroll
    for (int i = 0; i < 20; ++i) F.in[i] = args.in[i];
    F.out = args.out; F.ws = args.ws;
    const int lo = args.ph_lo, hi = args.ph_hi;
#ifdef DBG_ONLY
#define IN(k) ((k) == DBG_ONLY && lo <= (k) && (k) < hi)
#else
#define IN(k) (lo <= (k) && (k) < hi)
#endif
#define SEAM(k) do { if (IN(k) && IN((k) + 1)) grid.sync(); } while (0)
    unsigned char* ws = args.ws;
    const float* mod = (const float*)(ws + WS_MOD);
    if (IN(0)) { phase0(F); } SEAM(0);
    if (IN(1)) { phase1(F); } SEAM(1);
    if (IN(2)) {
        pg8::Gemm g{(const pg8::bf16_t*)(ws + WS_XS), (const pg8::bf16_t*)(ws + WS_W1A), M, NFF, D}; pg8::StaticOrder S; S.init(M, NFF, F.G, F.bid);
        pg8::EpiSwiglu E{(pg8::bf16_t*)(ws + WS_ACT), FF, (const float*)(ws + WS_RS0), (const float*)(ws + WS_SB1), NFF};
        pg8::gemm_phase<pg8::EpiSwiglu, pg8::StaticOrder, true, true>(F.lds, g, S, E);
    } SEAM(2);
    if (IN(3)) {
        pg8::Gemm g{(const pg8::bf16_t*)(ws + WS_ACT), (const pg8::bf16_t*)(ws + WS_W2A), M, D, FF}; pg8::StaticOrder S; S.init(M, D, F.G, F.bid);
        pg8::EpiRes<false> E{F.in[0], (float*)(ws + WS_X1), (pg8::bf16_t*)(ws + WS_XS), (float*)(ws + WS_RS1), mod + 2048, mod + 3072 + 1024, F.in[7], 0.5f, 0.f};
        pg8::gemm_phase<pg8::EpiRes<false>, pg8::StaticOrder, true, true>(F.lds, g, S, E);
    } SEAM(3);
    if (IN(4)) {
        pg8::Gemm g{(const pg8::bf16_t*)(ws + WS_XS), (const pg8::bf16_t*)(ws + WS_WMI), M, NMIX, D}; pg8::StaticOrder S; S.init(M, NMIX, F.G, F.bid);
        pg8::EpiProj E{(pg8::bf16_t*)(ws + WS_PROJ), NMIX, (const float*)(ws + WS_RS1), (const float*)(ws + WS_SB2), NMIX, 512};
        pg8::gemm_phase<pg8::EpiProj, pg8::StaticOrder, true, true>(F.lds, g, S, E);
    } SEAM(4);
    if (IN(5)) { phase5(F); } SEAM(5);
    if (IN(6)) {
        pg8::Gemm g{(const pg8::bf16_t*)(ws + WS_YCAT), (const pg8::bf16_t*)(ws + WS_WMO), M, D, D}; pg8::StaticOrder S; S.init(M, D, F.G, F.bid);
        pg8::EpiRes<false> E{(const float*)(ws + WS_X1), (float*)(ws + WS_X1), (pg8::bf16_t*)(ws + WS_XS), (float*)(ws + WS_RS2), mod + 3072 + 2048, mod + 6144 + 1024, F.in[16], 1.0f, 0.f};
        pg8::gemm_phase<pg8::EpiRes<false>, pg8::StaticOrder, true, true>(F.lds, g, S, E);
    } SEAM(6);
    if (IN(7)) {
        pg8::Gemm g{(const pg8::bf16_t*)(ws + WS_XS), (const pg8::bf16_t*)(ws + WS_W1B), M, NFF, D}; pg8::StaticOrder S; S.init(M, NFF, F.G, F.bid);
        pg8::EpiSwiglu E{(pg8::bf16_t*)(ws + WS_ACT), FF, (const float*)(ws + WS_RS2), (const float*)(ws + WS_SB3), NFF};
        pg8::gemm_phase<pg8::EpiSwiglu, pg8::StaticOrder, true, true>(F.lds, g, S, E);
    } SEAM(7);
    if (IN(8)) {
        pg8::Gemm g{(const pg8::bf16_t*)(ws + WS_ACT), (const pg8::bf16_t*)(ws + WS_W2B), M, D, FF}; pg8::StaticOrder S; S.init(M, D, F.G, F.bid);
        pg8::EpiRes<true> E{(const float*)(ws + WS_X1), F.out, nullptr, nullptr, mod + 6144 + 2048, nullptr, nullptr, 0.5f, 0.f};
        pg8::gemm_phase<pg8::EpiRes<true>, pg8::StaticOrder, true, true>(F.lds, g, S, E);
    } SEAM(8);
    if (IN(9)) { phase9(F); }
#undef IN
#undef SEAM
}
extern "C" void kernel_launch(void* const* d_in, const int* in_sizes, int n_in, void* d_out, int out_size, void* d_ws, size_t ws_size, hipStream_t stream) {
    static int grid = 0;
    if (grid == 0) {
        if (n_in != 20 || in_sizes[0] != M * D || out_size != M * D || ws_size < WS_END) { fprintf(stderr, "kernel_launch: unexpected shapes (n_in %d, in0 %d, out %d, ws %zu)\n", n_in, n_in > 0 ? in_sizes[0] : -1, out_size, ws_size); grid = -1; return; }
        int dev = 0, cus = 0, per_cu = 0;
        if (hipGetDevice(&dev) != hipSuccess || hipDeviceGetAttribute(&cus, hipDeviceAttributeMultiprocessorCount, dev) != hipSuccess) { grid = -1; return; }
        if (hipFuncSetAttribute((const void*)mk_fwd, hipFuncAttributeMaxDynamicSharedMemorySize, LDS_BYTES) != hipSuccess) { fprintf(stderr, "kernel_launch: hipFuncSetAttribute failed\n"); grid = -1; return; }
        if (hipOccupancyMaxActiveBlocksPerMultiprocessor(&per_cu, (const void*)mk_fwd, NTHREADS, LDS_BYTES) != hipSuccess || per_cu < 1) { fprintf(stderr, "kernel_launch: occupancy query says %d\n", per_cu); per_cu = 1; }
        (void)hipGetLastError();
        grid = cus * 1;
    }
    if (grid < 0) return;
    Args a{};
    for (int i = 0; i < 20; ++i) a.in[i] = (const float*)d_in[i];
    a.out = (float*)d_out; a.ws = (unsigned char*)d_ws;
#if MK_N_LAUNCHES == 1
    a.ph_lo = 0; a.ph_hi = NPHASE;
    void* kargs[] = {&a};
    hipError_t e = hipLaunchCooperativeKernel((const void*)mk_fwd, dim3(grid), dim3(NTHREADS), kargs, LDS_BYTES, stream);
    if (e != hipSuccess) fprintf(stderr, "kernel_launch: cooperative launch failed: %s (grid %d)\n", hipGetErrorString(e), grid);
#else
    for (int p = 0; p < NPHASE; ++p) { a.ph_lo = p; a.ph_hi = p + 1; hipLaunchKernelGGL(mk_fwd, dim3(grid), dim3(NTHREADS), LDS_BYTES, stream, a); }
#endif
}
```

```cpp
#include <hip/hip_runtime.h>
#include <hip/hip_cooperative_groups.h>
#include <cstdio>
#include <cstdint>
namespace cg = cooperative_groups;
namespace pg8 {
#define PG8_LAS __attribute__((address_space(3)))
typedef unsigned short bf16_t;
typedef short bf16x8 __attribute__((ext_vector_type(8)));
typedef float f32x4 __attribute__((ext_vector_type(4)));
typedef unsigned u32x4 __attribute__((ext_vector_type(4)));
constexpr int BM = 256, BK = 64, HALF = 128, HTB = HALF * BK * 2  , STAGE_BYTES = 8 * HTB, NXCD = 8, WGM = 8;

__host__ __device__ __forceinline__ int lds_byte(int r, int c) { const int st = (r >> 4) * 2 + (c >> 5), rr = r & 15, cc = c & 31, ob = rr * 64 + cc * 2; return st * 1024 + (ob ^ (((ob >> 9) & 1) << 5)); }
__host__ __device__ __forceinline__ void stage_rc(int b, int& R, int& C) { const int st = b / 1024, sb = b % 1024, swz = sb ^ (((sb >> 9) & 1) << 5); R = (st >> 1) * 16 + swz / 64; C = (st & 1) * 32 + (swz % 64) / 2; }
__host__ __device__ __forceinline__ int perm32(int rho) { const int n = rho >> 4, i = rho & 15; return 8 * (i >> 2) + 4 * n + (i & 3); }

struct Unit { int pm, pn; };
struct Gemm { const bf16_t* A; const bf16_t* Bt; int M, N, K; };

struct StaticOrder {
    int nM, nN, nwg, G, c;
    __host__ __device__ void init(int M, int N, int G_, int c_) { nM = M / BM; nN = N / BM; nwg = nM * nN; G = G_; c = c_; }
    __host__ __device__ bool next(int i, Unit& u) const {
        const long L = (long)i * G + c; if (L >= nwg) return false;
        int wgid = (int)L; { const int q = nwg / NXCD, r = nwg % NXCD, xcd = wgid % NXCD, off = wgid / NXCD; wgid = (xcd < r ? xcd * (q + 1) : r * (q + 1) + (xcd - r) * q) + off; }
        const int nig = WGM * nN, gid = wgid / nig, fm = gid * WGM, gsz = (nM - fm) < WGM ? (nM - fm) : WGM;
        u.pm = fm + ((wgid % nig) % gsz); u.pn = (wgid % nig) / gsz; return true;
    }
    __device__ __forceinline__ void a_ready(const Unit&) const {}
    __device__ __forceinline__ void done(const Unit&) const {}
};

__device__ __forceinline__ unsigned cvt_pk_bf16(float lo, float hi) { unsigned r; asm volatile("v_cvt_pk_bf16_f32 %0, %1, %2" : "=v"(r) : "v"(lo), "v"(hi)); return r; }
typedef float f32x2 __attribute__((ext_vector_type(2)));
__device__ __forceinline__ f32x2 gelu_pk(f32x2 v) {
    const f32x2 av = __builtin_elementwise_abs(v), d = av * 0.2316418882f + 1.0f;
    f32x2 t; t.x = __builtin_amdgcn_rcpf(d.x); t.y = __builtin_amdgcn_rcpf(d.y);
    f32x2 q = t * 0.5307027145f + (-0.7265760135f); q = q * t + 0.7107068705f; q = q * t + (-0.142248368f); q = q * t + 0.127414796f; q = q * t;
    const f32x2 s = (v * v) * (-0.72134752044f);
    f32x2 e; e.x = __builtin_amdgcn_exp2f(s.x); e.y = __builtin_amdgcn_exp2f(s.y);
    const f32x2 m = v * (q * e), r = v - m;
    f32x2 o; o.x = v.x < 0.f ? m.x : r.x; o.y = v.y < 0.f ? m.y : r.y; return o;
}

template <int ACT  > struct EpiBf16 {
    static constexpr bool PERM = true, AFTER_DRAIN = false; static_assert(ACT == 0 || ACT == 1, "EpiBf16: ACT is 0 (none) or 1 (gelu_pk)");
    bf16_t* O; int ldc; const float* bias; int split_cols; size_t split_stride; float scale0;
    __device__ __forceinline__ void operator()(const f32x4 (&acc)[2][2][4][2], const Unit& u, int wr, int wc, int fr, int fq) const {
        const int row0 = u.pm * BM + wr * 64 + fr; int colt = u.pn * BM; bf16_t* base = O;
        float sc = 1.f; if (split_cols) { const int t = colt / split_cols; base += (size_t)t * split_stride; colt -= t * split_cols; if (t == 0) sc = scale0; }
        const int col0 = colt + wc * 32 + 8 * fq, bcol0 = u.pn * BM + wc * 32 + 8 * fq;
        f32x4 bv[2][2];
#pragma unroll
        for (int bj = 0; bj < 2; ++bj)
#pragma unroll
            for (int n = 0; n < 2; ++n) bv[bj][n] = bias ? *(const f32x4*)(bias + bcol0 + bj * HALF + 4 * n) : (f32x4){0.f, 0.f, 0.f, 0.f};
#pragma unroll
        for (int ai = 0; ai < 2; ++ai)
#pragma unroll
            for (int m = 0; m < 4; ++m) { bf16_t* rowp = base + (size_t)(row0 + ai * HALF + m * 16) * ldc + col0;
#pragma unroll
                for (int bj = 0; bj < 2; ++bj) { f32x4 v0 = acc[ai][bj][m][0] + bv[bj][0], v1 = acc[ai][bj][m][1] + bv[bj][1];
                    if (ACT == 1) { f32x2 a = gelu_pk((f32x2){v0[0], v0[1]}), b = gelu_pk((f32x2){v0[2], v0[3]}), c = gelu_pk((f32x2){v1[0], v1[1]}), d = gelu_pk((f32x2){v1[2], v1[3]});
                        v0 = (f32x4){a.x, a.y, b.x, b.y}; v1 = (f32x4){c.x, c.y, d.x, d.y}; }
                    v0 = v0 * sc; v1 = v1 * sc; u32x4 w; w.x = cvt_pk_bf16(v0[0], v0[1]); w.y = cvt_pk_bf16(v0[2], v0[3]); w.z = cvt_pk_bf16(v1[0], v1[1]); w.w = cvt_pk_bf16(v1[2], v1[3]);
                    *(u32x4*)(rowp + bj * HALF) = w; } }
    }
};
__device__ __forceinline__ void row_factors(const float* rs, int row0, int fq, float (&rf)[2][4]) {
#pragma unroll
    for (int ai = 0; ai < 2; ++ai)
#pragma unroll
        for (int m = 0; m < 4; ++m) {
            const f32x4 p = *(const f32x4*)(rs + (size_t)(row0 + ai * HALF + m * 16) * 16 + 4 * fq);
            float s = (p[0] + p[1]) + (p[2] + p[3]);
            s += __shfl_xor(s, 16); s += __shfl_xor(s, 32);
            rf[ai][m] = rsqrtf(s * (1.0f / 1024.0f) + 1e-6f);
        }
}
__device__ __forceinline__ float sigmoid_fast(float v) { return __builtin_amdgcn_rcpf(1.0f + __builtin_amdgcn_exp2f(-1.44269504089f * v)); }
__device__ __forceinline__ float gelu_tanh(float v) { const float u = 0.7978845608f * (v + 0.044715f * v * v * v); return v * sigmoid_fast(2.0f * u); }

struct EpiSwiglu {
    static constexpr bool PERM = true, AFTER_DRAIN = false;
    bf16_t* O; int ldo; const float* rs; const float* sb; int nsb;
    __device__ __forceinline__ void operator()(const f32x4 (&acc)[2][2][4][2], const Unit& u, int wr, int wc, int fr, int fq) const {
        const int row0 = u.pm * BM + wr * 64 + fr, b = (u.pm * BM) >> 13;
        float rf[2][4]; row_factors(rs, row0, fq, rf);
        const float* sbp = sb + (size_t)b * nsb + u.pn * BM + wc * 32 + 8 * fq;
        f32x4 bg[2], bu[2];
#pragma unroll
        for (int n = 0; n < 2; ++n) { bg[n] = *(const f32x4*)(sbp + 4 * n); bu[n] = *(const f32x4*)(sbp + HALF + 4 * n); }
        const int col0 = u.pn * HALF + wc * 32 + 8 * fq;
#pragma unroll
        for (int ai = 0; ai < 2; ++ai)
#pragma unroll
            for (int m = 0; m < 4; ++m) {
                const float r = rf[ai][m]; float o[8];
#pragma unroll
                for (int n = 0; n < 2; ++n)
#pragma unroll
                    for (int j = 0; j < 4; ++j) { const float g = acc[ai][0][m][n][j] * r + bg[n][j], uu = acc[ai][1][m][n][j] * r + bu[n][j]; o[4 * n + j] = g * sigmoid_fast(g) * uu; }
                u32x4 w; w.x = cvt_pk_bf16(o[0], o[1]); w.y = cvt_pk_bf16(o[2], o[3]); w.z = cvt_pk_bf16(o[4], o[5]); w.w = cvt_pk_bf16(o[6], o[7]);
                *(u32x4*)(O + (size_t)(row0 + ai * HALF + m * 16) * ldo + col0) = w;
            }
    }
};
struct EpiProj {
    static constexpr bool PERM = true, AFTER_DRAIN = false;
    bf16_t* O; int ldo; const float* rs; const float* sb; int nsb; int gelu_from;
    __device__ __forceinline__ void operator()(const f32x4 (&acc)[2][2][4][2], const Unit& u, int wr, int wc, int fr, int fq) const {
        const int row0 = u.pm * BM + wr * 64 + fr, b = (u.pm * BM) >> 13;
        float rf[2][4]; row_factors(rs, row0, fq, rf);
        const int col0 = u.pn * BM + wc * 32 + 8 * fq;
        const float* sbp = sb + (size_t)b * nsb + col0;
        f32x4 bv[2][2];
#pragma unroll
        for (int bj = 0; bj < 2; ++bj)
#pragma unroll
            for (int n = 0; n < 2; ++n) bv[bj][n] = *(const f32x4*)(sbp + bj * HALF + 4 * n);
        const bool act = (u.pn * BM) >= gelu_from;
#pragma unroll
        for (int ai = 0; ai < 2; ++ai)
#pragma unroll
            for (int m = 0; m < 4; ++m) {
                const float r = rf[ai][m]; bf16_t* rowp = O + (size_t)(row0 + ai * HALF + m * 16) * ldo + col0;
#pragma unroll
                for (int bj = 0; bj < 2; ++bj) { float o[8];
#pragma unroll
                    for (int n = 0; n < 2; ++n)
#pragma unroll
                        for (int j = 0; j < 4; ++j) { const float v = acc[ai][bj][m][n][j] * r + bv[bj][n][j]; o[4 * n + j] = act ? gelu_tanh(v) : v; }
                    u32x4 w; w.x = cvt_pk_bf16(o[0], o[1]); w.y = cvt_pk_bf16(o[2], o[3]); w.z = cvt_pk_bf16(o[4], o[5]); w.w = cvt_pk_bf16(o[6], o[7]);
                    *(u32x4*)(rowp + bj * HALF) = w; }
            }
    }
};
template <bool LAST> struct EpiRes {
    static constexpr bool PERM = true, AFTER_DRAIN = false;
    const float* xold; float* xnew; bf16_t* xs; float* rs; const float* gate; const float* scale_next; const float* ng; float coef, pad_;
    __device__ __forceinline__ void operator()(const f32x4 (&acc)[2][2][4][2], const Unit& u, int wr, int wc, int fr, int fq) const {
        const int row0 = u.pm * BM + wr * 64 + fr, b = (u.pm * BM) >> 13;
        const int col0 = u.pn * BM + wc * 32 + 8 * fq;
        f32x4 gt[2][2], gs[2][2];
#pragma unroll
        for (int bj = 0; bj < 2; ++bj)
#pragma unroll
            for (int n = 0; n < 2; ++n) { const int c = col0 + bj * HALF + 4 * n;
                gt[bj][n] = *(const f32x4*)(gate + (size_t)b * 9216 + c) * coef;
                if (!LAST) gs[bj][n] = *(const f32x4*)(ng + c) * (*(const f32x4*)(scale_next + (size_t)b * 9216 + c) + 1.0f); }
#pragma unroll
        for (int ai = 0; ai < 2; ++ai)
#pragma unroll
            for (int m = 0; m < 4; ++m) {
                const size_t off = (size_t)(row0 + ai * HALF + m * 16) * 1024 + col0; float ss = 0.f;
#pragma unroll
                for (int bj = 0; bj < 2; ++bj) { f32x4 xn[2];
#pragma unroll
                    for (int n = 0; n < 2; ++n) { xn[n] = *(const f32x4*)(xold + off + bj * HALF + 4 * n) + gt[bj][n] * acc[ai][bj][m][n];
                        *(f32x4*)(xnew + off + bj * HALF + 4 * n) = xn[n]; }
                    if (!LAST) { ss += (xn[0][0] * xn[0][0] + xn[0][1] * xn[0][1]) + (xn[0][2] * xn[0][2] + xn[0][3] * xn[0][3]) + (xn[1][0] * xn[1][0] + xn[1][1] * xn[1][1]) + (xn[1][2] * xn[1][2] + xn[1][3] * xn[1][3]);
                        const f32x4 a = xn[0] * gs[bj][0], c = xn[1] * gs[bj][1];
                        u32x4 w; w.x = cvt_pk_bf16(a[0], a[1]); w.y = cvt_pk_bf16(a[2], a[3]); w.z = cvt_pk_bf16(c[0], c[1]); w.w = cvt_pk_bf16(c[2], c[3]);
                        *(u32x4*)(xs + off + bj * HALF) = w; } }
                if (!LAST) { ss += __shfl_xor(ss, 16); ss += __shfl_xor(ss, 32);
                    if (fq == 0) rs[(size_t)(row0 + ai * HALF + m * 16) * 16 + u.pn * 4 + wc] = ss; }
            }
    }
};

template <class Epi, class Sched, bool ALIGN_EPI = false, bool SP2 = false>
__device__ __forceinline__ void gemm_phase(PG8_LAS unsigned char* lds, const Gemm g, const Sched S, const Epi E) {
    const int tid = threadIdx.x, wid = __builtin_amdgcn_readfirstlane(tid >> 6), lane = tid & 63, wr = wid >> 2, wc = wid & 3, fr = lane & 15, fq = lane >> 4;
    const int K = g.K, nt = K / BK;
    unsigned voffA[2], voffB[2];
#pragma unroll
    for (int i = 0; i < 2; ++i) { int R, C; stage_rc(tid * 16 + i * 8192, R, C); const int Rb = Epi::PERM ? ((R & ~31) + perm32(R & 31)) : R;
        voffA[i] = (unsigned)(R * K + C) * 2u; voffB[i] = (unsigned)(Rb * K + C) * 2u; }
    const size_t kstep = (size_t)(BK * 2);
    const size_t hstep = (size_t)HALF * K * 2;
    const size_t tstep = 2 * hstep;
    const unsigned ldsw = (unsigned)wid * 1024u;
    const int aoff = lds_byte(wr * 64 + fr, fq * 8), boff = lds_byte(wc * 32 + fr, fq * 8);
#define PG8_SA(b, h) (((b) * 2 + (h)) * HTB)
#define PG8_SB(b, h) ((4 + (b) * 2 + (h)) * HTB)
#define PG8_STAGE(bufoff, gbase, voff) do { _Pragma("unroll") for (int _i = 0; _i < 2; ++_i) \
        __builtin_amdgcn_global_load_lds((const unsigned*)((const char*)(gbase) + (voff)[_i]), (PG8_LAS unsigned*)(lds + (bufoff) + ldsw + _i * 8192), 16, 0, 0); } while (0)
#define PG8_LDA(dst, b, h) do { _Pragma("unroll") for (int m = 0; m < 4; ++m) _Pragma("unroll") for (int k = 0; k < 2; ++k) dst[m][k] = *(const PG8_LAS bf16x8*)(lds + PG8_SA(b, h) + aoff + m * 2048 + k * 1024); } while (0)
#define PG8_LDB(dst, b, h) do { _Pragma("unroll") for (int n = 0; n < 2; ++n) _Pragma("unroll") for (int k = 0; k < 2; ++k) dst[n][k] = *(const PG8_LAS bf16x8*)(lds + PG8_SB(b, h) + boff + n * 2048 + k * 1024); } while (0)
#define PG8_MMA(ai, bj, At, Bt) do { __builtin_amdgcn_s_setprio(1); _Pragma("unroll") for (int m = 0; m < 4; ++m) _Pragma("unroll") for (int n = 0; n < 2; ++n) _Pragma("unroll") for (int k = 0; k < 2; ++k) \
        acc[ai][bj][m][n] = __builtin_amdgcn_mfma_f32_16x16x32_bf16(Bt[n][k], At[m][k], acc[ai][bj][m][n], 0, 0, 0); __builtin_amdgcn_s_setprio(0); } while (0)
#define PG8_WAIT_V(n) asm volatile("s_waitcnt vmcnt(" #n ")" ::: "memory")
#define PG8_WAIT_L(n) asm volatile("s_waitcnt lgkmcnt(" #n ")" ::: "memory")
#define PG8_BAR __builtin_amdgcn_s_barrier()
#define PG8_SCHED __builtin_amdgcn_sched_barrier(0)
    Unit cur, nxt; int ui = 0;
    if (!S.next(0, cur)) return;
    f32x4 acc[2][2][4][2];
#pragma unroll
    for (int a = 0; a < 2; ++a)
#pragma unroll
        for (int b = 0; b < 2; ++b)
#pragma unroll
            for (int m = 0; m < 4; ++m)
#pragma unroll
                for (int n = 0; n < 2; ++n) acc[a][b][m][n] = (f32x4){0.f, 0.f, 0.f, 0.f};
    bf16x8 At[4][2], B0[2][2], B1[2][2];
    const char* cA = (const char*)g.A + (size_t)cur.pm * tstep; const char* cB = (const char*)g.Bt + (size_t)cur.pn * tstep;
    S.a_ready(cur);
    if constexpr (SP2) {
        PG8_STAGE(PG8_SB(0, 0), cB, voffB); PG8_STAGE(PG8_SB(0, 1), cB + hstep, voffB); PG8_STAGE(PG8_SA(0, 0), cA, voffA); PG8_STAGE(PG8_SA(0, 1), cA + hstep, voffA);
        if (wr == 1) PG8_BAR;
        PG8_WAIT_V(2); PG8_BAR;
        PG8_STAGE(PG8_SB(1, 0), cB + kstep, voffB); PG8_STAGE(PG8_SA(1, 0), cA + kstep, voffA); PG8_STAGE(PG8_SB(1, 1), cB + hstep + kstep, voffB);
        PG8_WAIT_V(6); PG8_BAR;
    } else {
        PG8_STAGE(PG8_SB(0, 0), cB, voffB); PG8_STAGE(PG8_SA(0, 0), cA, voffA); PG8_STAGE(PG8_SB(0, 1), cB + hstep, voffB); PG8_STAGE(PG8_SA(0, 1), cA + hstep, voffA);
        if (wr == 1) PG8_BAR;
        PG8_WAIT_V(4); PG8_BAR;
        PG8_STAGE(PG8_SB(1, 0), cB + kstep, voffB); PG8_STAGE(PG8_SA(1, 0), cA + kstep, voffA); PG8_STAGE(PG8_SB(1, 1), cB + hstep + kstep, voffB);
        PG8_WAIT_V(6); PG8_BAR;
    }
    for (;;) {
        const bool has_next = S.next(ui + 1, nxt);
        const char* nA = has_next ? (const char*)g.A + (size_t)nxt.pm * tstep : cA; const char* nB = has_next ? (const char*)g.Bt + (size_t)nxt.pn * tstep : cB;
        for (int t = 0; t < nt; t += 2) {
            const bool last = (t == nt - 2);
            const char* a1 = cA + (size_t)(t + 1) * kstep;
            const char* a2 = last ? nA : cA + (size_t)(t + 2) * kstep; const char* b2 = last ? nB : cB + (size_t)(t + 2) * kstep;
            const char* a3 = a2 + kstep; const char* b3 = b2 + kstep;
            if (last && has_next) S.a_ready(nxt);
            if constexpr (SP2) {
            PG8_LDB(B0, 0, 0); PG8_LDB(B1, 0, 1); PG8_SCHED; PG8_LDA(At, 0, 0); PG8_STAGE(PG8_SA(1, 1), a1 + hstep, voffA);
            PG8_WAIT_V(8); PG8_WAIT_L(0); PG8_BAR; PG8_MMA(0, 0, At, B0); PG8_MMA(0, 1, At, B1); PG8_BAR; PG8_SCHED;
            PG8_LDA(At, 0, 1); PG8_STAGE(PG8_SB(0, 0), b2, voffB); PG8_STAGE(PG8_SB(0, 1), b2 + hstep, voffB); PG8_STAGE(PG8_SA(0, 0), a2, voffA);
            PG8_WAIT_V(8); PG8_WAIT_L(0); PG8_BAR; PG8_MMA(1, 0, At, B0); PG8_MMA(1, 1, At, B1); PG8_BAR; PG8_SCHED;
            PG8_LDB(B0, 1, 0); PG8_LDB(B1, 1, 1); PG8_SCHED; PG8_LDA(At, 1, 0); PG8_STAGE(PG8_SA(0, 1), a2 + hstep, voffA);
            PG8_WAIT_V(8); PG8_WAIT_L(0); PG8_BAR; PG8_MMA(0, 0, At, B0); PG8_MMA(0, 1, At, B1); PG8_BAR; PG8_SCHED;
            PG8_LDA(At, 1, 1); PG8_STAGE(PG8_SB(1, 0), b3, voffB); PG8_STAGE(PG8_SB(1, 1), b3 + hstep, voffB); PG8_STAGE(PG8_SA(1, 0), a3, voffA);
            PG8_WAIT_V(8); PG8_WAIT_L(0); PG8_BAR; PG8_MMA(1, 0, At, B0); PG8_MMA(1, 1, At, B1); PG8_BAR; PG8_SCHED;
            } else {
            PG8_LDB(B0, 0, 0); PG8_SCHED; PG8_LDA(At, 0, 0); PG8_STAGE(PG8_SA(1, 1), a1 + hstep, voffA);
            PG8_WAIT_L(8); PG8_BAR; PG8_WAIT_L(0); PG8_MMA(0, 0, At, B0); PG8_BAR; PG8_SCHED;
            PG8_LDB(B1, 0, 1); PG8_STAGE(PG8_SB(0, 0), b2, voffB);
            PG8_BAR; PG8_WAIT_L(0); PG8_MMA(0, 1, At, B1); PG8_BAR;
            PG8_LDA(At, 0, 1); PG8_STAGE(PG8_SA(0, 0), a2, voffA);
            PG8_BAR; PG8_WAIT_L(0); PG8_MMA(1, 0, At, B0); PG8_BAR; PG8_SCHED;
            PG8_STAGE(PG8_SB(0, 1), b2 + hstep, voffB);
            PG8_WAIT_V(6); PG8_BAR; PG8_MMA(1, 1, At, B1); PG8_BAR;
            PG8_LDB(B0, 1, 0); PG8_SCHED; PG8_LDA(At, 1, 0); PG8_STAGE(PG8_SA(0, 1), a2 + hstep, voffA);
            PG8_WAIT_L(8); PG8_BAR; PG8_WAIT_L(0); PG8_MMA(0, 0, At, B0); PG8_BAR; PG8_SCHED;
            PG8_LDB(B1, 1, 1); PG8_STAGE(PG8_SB(1, 0), b3, voffB);
            PG8_BAR; PG8_WAIT_L(0); PG8_MMA(0, 1, At, B1); PG8_BAR;
            PG8_LDA(At, 1, 1); PG8_STAGE(PG8_SA(1, 0), a3, voffA);
            PG8_BAR; PG8_WAIT_L(0); PG8_MMA(1, 0, At, B0); PG8_BAR; PG8_SCHED;
            PG8_STAGE(PG8_SB(1, 1), b3 + hstep, voffB);
            PG8_WAIT_V(6); PG8_BAR; PG8_MMA(1, 1, At, B1); PG8_BAR;
            }
        }
        if constexpr (ALIGN_EPI) { if (wr == 0) PG8_BAR; }
        if constexpr (!Epi::AFTER_DRAIN) { E(acc, cur, wr, wc, fr, fq); S.done(cur); }
        if (!has_next) break;
#pragma unroll
        for (int a = 0; a < 2; ++a)
#pragma unroll
            for (int b = 0; b < 2; ++b)
#pragma unroll
                for (int m = 0; m < 4; ++m)
#pragma unroll
                    for (int n = 0; n < 2; ++n) acc[a][b][m][n] = (f32x4){0.f, 0.f, 0.f, 0.f};
        cur = nxt; cA = nA; cB = nB; ++ui;
        if constexpr (ALIGN_EPI) { if (wr == 1) PG8_BAR; }
    }
    PG8_WAIT_V(0);
    if constexpr (!ALIGN_EPI) { if (wr == 0) PG8_BAR; }
    PG8_BAR;
    if constexpr (Epi::AFTER_DRAIN) { E.fused(acc, cur, wr, wc, fr, fq, lds, wid, lane); S.done(cur); }
#undef PG8_SA
#undef PG8_SB
#undef PG8_STAGE
#undef PG8_LDA
#undef PG8_LDB
#undef PG8_MMA
#undef PG8_WAIT_V
#undef PG8_WAIT_L
#undef PG8_BAR
#undef PG8_SCHED
}
}
#ifndef MK_N_LAUNCHES
#define MK_N_LAUNCHES 1
#endif
constexpr int NWAVES = 8, NTHREADS = 512;
constexpr int BATCH = 4, SEQ = 8192, D = 1024, M = BATCH * SEQ, FF = 2816, NFF = 2 * FF, NMIX = 1536, NMOD = 9216, CHUNK = 128, NCHUNK = M / CHUNK;
constexpr int NPHASE = 10;
constexpr size_t MiB = 1u << 20;
constexpr size_t WS_CTL = 512 * 1024, CTL_ZERO_BYTES = 16384;
constexpr size_t WS_MOD = 0;
constexpr size_t WS_SB1 = 1 * MiB, WS_SB2 = WS_SB1 + 128 * 1024, WS_SB3 = WS_SB1 + 256 * 1024;
constexpr size_t WS_RS0 = 2 * MiB, WS_RS1 = 4 * MiB, WS_RS2 = 6 * MiB;
constexpr size_t WS_W1A = 8 * MiB, WS_W2A = 20 * MiB, WS_WMI = 26 * MiB, WS_WMO = 30 * MiB, WS_W1B = 32 * MiB, WS_W2B = 44 * MiB, WS_WPT = 50 * MiB, WS_WSP = 51 * MiB;
constexpr size_t WS_XS = 64 * MiB;
constexpr size_t WS_X1 = 128 * MiB;
constexpr size_t WS_ACT = 256 * MiB;
constexpr size_t WS_PROJ = 256 * MiB, WS_YCAT = 352 * MiB;
constexpr size_t WS_END = 432 * MiB;
constexpr int LDS_BAR_OFF = 131072;
constexpr int LDS_BYTES = 147456;

#define GAS __attribute__((address_space(1)))
#define LAS __attribute__((address_space(3)))
typedef unsigned short bf16;
typedef unsigned v4u __attribute__((ext_vector_type(4)));
typedef unsigned v2u __attribute__((ext_vector_type(2)));
typedef float f32x4 __attribute__((ext_vector_type(4)));
typedef float f32x2 __attribute__((ext_vector_type(2)));
typedef short bf16x8 __attribute__((ext_vector_type(8)));
#define LDS_WAIT() asm volatile("s_waitcnt lgkmcnt(0)" ::: "memory")
__device__ __forceinline__ unsigned f2bf(float f) { unsigned u = __builtin_bit_cast(unsigned, f); return (u + 0x7fffu + ((u >> 16) & 1u)) >> 16; }
__device__ __forceinline__ unsigned pk2(float lo, float hi) { return f2bf(lo) | (f2bf(hi) << 16); }
__device__ __forceinline__ float bflo(unsigned w) { return __uint_as_float(w << 16); }
__device__ __forceinline__ float bfhi(unsigned w) { return __uint_as_float(w & 0xffff0000u); }
__device__ __forceinline__ float wave_sum(float v) {
#pragma unroll
    for (int o = 1; o < 64; o <<= 1) v += __shfl_xor(v, o);
    return v;
}

#define XB_TMO      128
#define XB_XCNT(j)  (256  + 64 * (j))
#define XB_XSUB(j)  (1280 + 64 * (j))
#define XB_XGEN(j)  (2304 + 64 * (j))
#define XB_TOP      3328
#define XB_TOPGEN   3392
#define XCD_BAR_WORDS 3456
#define XB_SPIN_CAP (1u << 18)

__device__ __forceinline__ unsigned xb_ld(unsigned* p)              { return __hip_atomic_load(p, __ATOMIC_RELAXED, __HIP_MEMORY_SCOPE_AGENT); }
__device__ __forceinline__ unsigned xb_add(unsigned* p, unsigned v) { return __hip_atomic_fetch_add(p, v, __ATOMIC_RELAXED, __HIP_MEMORY_SCOPE_AGENT); }
__device__ __forceinline__ unsigned xb_xcc_id() { return (unsigned)__builtin_amdgcn_s_getreg((3 << 11) | 20) & 0xFu; }
#define XB_SPIN(cond, bar) do { unsigned _sp = 0; while (cond) { __builtin_amdgcn_s_sleep(1); \
    if ((++_sp & 255u) == 0u) { if (xb_ld(&(bar)[XB_TMO])) break; if (_sp > XB_SPIN_CAP) { atomicAdd(&(bar)[XB_TMO], 1u); break; } } } } while (0)

struct XcdBarrier {
    unsigned* bar; unsigned x;
    volatile LAS unsigned* st;
};

__device__ __forceinline__ XcdBarrier xcd_barrier_post(unsigned* bar, volatile LAS unsigned* st) {
    XcdBarrier b; b.bar = bar; b.x = xb_xcc_id(); b.st = st;
    if (threadIdx.x == 0) (void)xb_add(&bar[XB_XCNT(b.x)], 1u);
    return b;
}
__device__ __forceinline__ void xcd_barrier_complete(unsigned* bar, unsigned x, unsigned& nloc, unsigned& nx) {
    const unsigned G = gridDim.x * gridDim.y * gridDim.z;
    unsigned sum, cnt, mine, sp = 0u;
    for (;;) {
        sum = 0u; cnt = 0u; mine = 0u;
#pragma unroll
        for (unsigned j = 0; j < 16; ++j) { const unsigned c = xb_ld(&bar[XB_XCNT(j)]); sum += c; cnt += (c > 0u) ? 1u : 0u; mine = (j == x) ? c : mine; }
        if (sum == G) break;
        __builtin_amdgcn_s_sleep(1);
        if ((++sp & 255u) == 0u) { if (xb_ld(&bar[XB_TMO])) break; if (sp > XB_SPIN_CAP) { atomicAdd(&bar[XB_TMO], 1u); break; } }
    }
    nloc = mine > 0u ? mine : 1u; nx = cnt > 0u ? cnt : 1u;
}

__device__ __forceinline__ void xcd_barrier(const XcdBarrier& b) {
    asm volatile("s_waitcnt vmcnt(0)" ::: "memory");
    __syncthreads();
    if (threadIdx.x == 0) {
        unsigned* bar = b.bar;
        __builtin_amdgcn_s_waitcnt(0);
        unsigned nloc = b.st[0], nx = b.st[1];
        if (nloc == 0u) { xcd_barrier_complete(bar, b.x, nloc, nx); b.st[0] = nloc; b.st[1] = nx; }
        const unsigned old = xb_add(&bar[XB_XSUB(b.x)], 1u);
        const unsigned gen = old / nloc;
        if (old + 1u == (gen + 1u) * nloc) {
            __builtin_amdgcn_fence(__ATOMIC_RELEASE, "agent");
            asm volatile("s_waitcnt vmcnt(0)" ::: "memory");
            const unsigned og = xb_add(&bar[XB_TOP], 1u);
            const unsigned tg = og / nx;
            if (og + 1u == (tg + 1u) * nx) xb_add(&bar[XB_TOPGEN], 1u);
            else XB_SPIN(xb_ld(&bar[XB_TOPGEN]) == tg, bar);
            __builtin_amdgcn_fence(__ATOMIC_ACQUIRE, "agent");
            xb_add(&bar[XB_XGEN(b.x)], 1u);
            asm volatile("s_waitcnt vmcnt(0)" ::: "memory");
        } else {
            XB_SPIN(xb_ld(&bar[XB_XGEN(b.x)]) == gen, bar);
            __builtin_amdgcn_fence(__ATOMIC_ACQUIRE, "agent");
            asm volatile("s_waitcnt vmcnt(0)" ::: "memory");
        }
    }
    __syncthreads();
}

struct Ctx {
    LAS unsigned char* lds; int tid, lane, wave, bid, G;
    const float* in[20]; float* out; unsigned char* ws;
};

__device__ __forceinline__ void p0_transpose_item(const float* W, int K, int N, bf16* WT, int mode, LAS float* scr, int item, int lane) {
    const int nblk = N / 32, kb = item / nblk, nb = item % nblk, k0 = 64 * kb, n0 = 32 * nb;
    int r0 = n0;
    if (mode == 1) { r0 = (n0 < FF) ? (256 * (n0 >> 7) + (n0 & 127)) : (256 * ((n0 - FF) >> 7) + 128 + ((n0 - FF) & 127)); }
#pragma unroll 8
    for (int i = 0; i < 32; ++i) { const int kk = 2 * i + (lane >> 5); scr[kk * 33 + (lane & 31)] = W[(size_t)(k0 + kk) * N + n0 + (lane & 31)]; }
    LDS_WAIT(); asm volatile("" ::: "memory");
    const int c = lane & 7;
#pragma unroll
    for (int j = 0; j < 4; ++j) { const int n = (lane >> 3) + 8 * j; const LAS float* s = scr + (8 * c) * 33 + n;
        v4u o; o.x = pk2(s[0 * 33], s[1 * 33]); o.y = pk2(s[2 * 33], s[3 * 33]); o.z = pk2(s[4 * 33], s[5 * 33]); o.w = pk2(s[6 * 33], s[7 * 33]);
        *(GAS v4u*)(WT + (size_t)(r0 + n) * K + k0 + 8 * c) = o; }
    LDS_WAIT(); asm volatile("" ::: "memory");
}
__device__ __forceinline__ void p0_mod_item(Ctx& F, int item) {
    const float* c = F.in[1]; const float* wa = F.in[2]; const float* ba = F.in[3]; float* mod = (float*)(F.ws + WS_MOD);
    const int j0 = item * 128 + 2 * F.lane, kbeg = F.wave * 128;
    float a[4][2] = {};
#pragma unroll 8
    for (int k = 0; k < 128; ++k) {
        const f32x2 w = *(const f32x2*)(wa + (size_t)(kbeg + k) * NMOD + j0);
#pragma unroll
        for (int b = 0; b < 4; ++b) { const float cv = c[b * D + kbeg + k]; const float s = cv / (1.0f + __expf(-cv)); a[b][0] += s * w.x; a[b][1] += s * w.y; }
    }
    LAS float* red = (LAS float*)F.lds;
#pragma unroll
    for (int b = 0; b < 4; ++b) { red[(F.wave * 4 + b) * 128 + 2 * F.lane] = a[b][0]; red[(F.wave * 4 + b) * 128 + 2 * F.lane + 1] = a[b][1]; }
    __syncthreads();
    { const int b = F.tid >> 7, col = F.tid & 127; float s = ba[item * 128 + col];
#pragma unroll
      for (int w = 0; w < 8; ++w) s += red[(w * 4 + b) * 128 + col];
      mod[b * NMOD + item * 128 + col] = s; }
    __syncthreads();
}
__device__ __forceinline__ void phase0(Ctx& F) {
    for (int it = F.bid; it < NMOD / 128; it += F.G) p0_mod_item(F, it);
    LAS float* scr = (LAS float*)(F.lds + F.wave * 16384);
    const int gw = F.bid * NWAVES + F.wave, NGW = F.G * NWAVES;
    constexpr int I_1 = (D / 64) * (NFF / 32), I_2 = (FF / 64) * (D / 32), I_MI = (D / 64) * (NMIX / 32), I_MO = (D / 64) * (D / 32), I_P = 4 * 2 * 4;
    constexpr int NITEMS = 2 * I_1 + 2 * I_2 + I_MI + I_MO + I_P;
    for (int it = gw; it < NITEMS; it += NGW) {
        int r = it;
        if (r < I_1) { p0_transpose_item(F.in[5], D, NFF, (bf16*)(F.ws + WS_W1A), 1, scr, r, F.lane); continue; } r -= I_1;
        if (r < I_1) { p0_transpose_item(F.in[17], D, NFF, (bf16*)(F.ws + WS_W1B), 1, scr, r, F.lane); continue; } r -= I_1;
        if (r < I_2) { p0_transpose_item(F.in[6], FF, D, (bf16*)(F.ws + WS_W2A), 0, scr, r, F.lane); continue; } r -= I_2;
        if (r < I_2) { p0_transpose_item(F.in[18], FF, D, (bf16*)(F.ws + WS_W2B), 0, scr, r, F.lane); continue; } r -= I_2;
        if (r < I_MI) { p0_transpose_item(F.in[8], D, NMIX, (bf16*)(F.ws + WS_WMI), 0, scr, r, F.lane); continue; } r -= I_MI;
        if (r < I_MO) { p0_transpose_item(F.in[15], D, D, (bf16*)(F.ws + WS_WMO), 0, scr, r, F.lane); continue; } r -= I_MO;
        { const int g = r >> 3; p0_transpose_item(F.in[9] + (size_t)g * 128 * 128, 128, 128, (bf16*)(F.ws + WS_WPT) + (size_t)g * 128 * 128, 0, scr, r & 7, F.lane); }
    }
    { const float* wsp = F.in[13]; bf16* o = (bf16*)(F.ws + WS_WSP);
      for (int i = (F.bid * NTHREADS + F.tid) * 4; i < 8 * 128 * 128; i += F.G * NTHREADS * 4) {
          const f32x4 v = *(const f32x4*)(wsp + i); const int t = (i >> 7) & 127, s = i & 127;
          v2u w; w.x = pk2(s <= t ? v[0] : 0.f, s + 1 <= t ? v[1] : 0.f); w.y = pk2(s + 2 <= t ? v[2] : 0.f, s + 3 <= t ? v[3] : 0.f);
          *(GAS v2u*)(o + i) = w; } }
}
__device__ __forceinline__ void phase1(Ctx& F) {
    const float* mod = (const float*)(F.ws + WS_MOD);
    const int gw = F.bid * NWAVES + F.wave, NGW = F.G * NWAVES;
    const float* x = F.in[0]; const float* ng = F.in[4]; bf16* xs = (bf16*)(F.ws + WS_XS); float* rs0 = (float*)(F.ws + WS_RS0);
    for (int row = gw; row < M; row += NGW) {
        const int b = row >> 13; const GAS f32x4* xr = (const GAS f32x4*)(x + (size_t)row * D) + F.lane;
        GAS unsigned long long* o8 = (GAS unsigned long long*)(xs + (size_t)row * D) + F.lane; float ss = 0.f;
#pragma unroll
        for (int j = 0; j < 4; ++j) { const f32x4 v = xr[64 * j]; const int col = 4 * F.lane + 256 * j;
            const f32x4 gs = *(const f32x4*)(ng + col) * (*(const f32x4*)(mod + b * NMOD + 1024 + col) + 1.0f);
            ss += (v.x * v.x + v.y * v.y) + (v.z * v.z + v.w * v.w); const f32x4 h = v * gs;
            o8[64 * j] = (unsigned long long)pk2(h.x, h.y) | ((unsigned long long)pk2(h.z, h.w) << 32); }
        ss = wave_sum(ss);
        if (F.lane < 16) rs0[(size_t)row * 16 + F.lane] = ss * (1.0f / 16.0f);
    }
    for (int n = gw; n < NFF + NMIX + NFF; n += NGW) {
        const bf16* wrow; const float* sh; float* dst; int nn, ld;
        if (n < NFF) { nn = n; wrow = (const bf16*)(F.ws + WS_W1A); sh = mod + 0; dst = (float*)(F.ws + WS_SB1); ld = NFF; }
        else if (n < NFF + NMIX) { nn = n - NFF; wrow = (const bf16*)(F.ws + WS_WMI); sh = mod + 3072; dst = (float*)(F.ws + WS_SB2); ld = NMIX; }
        else { nn = n - NFF - NMIX; wrow = (const bf16*)(F.ws + WS_W1B); sh = mod + 6144; dst = (float*)(F.ws + WS_SB3); ld = NFF; }
        wrow += (size_t)nn * D; float a[4] = {0.f, 0.f, 0.f, 0.f};
#pragma unroll
        for (int h = 0; h < 2; ++h) { const int k0 = h * 512 + 8 * F.lane; const v4u w = *(const GAS v4u*)(wrow + k0);
            const float wf[8] = {bflo(w.x), bfhi(w.x), bflo(w.y), bfhi(w.y), bflo(w.z), bfhi(w.z), bflo(w.w), bfhi(w.w)};
#pragma unroll
            for (int b = 0; b < 4; ++b) { const f32x4 s0 = *(const f32x4*)(sh + b * NMOD + k0), s1 = *(const f32x4*)(sh + b * NMOD + k0 + 4);
                a[b] += (wf[0] * s0.x + wf[1] * s0.y) + (wf[2] * s0.z + wf[3] * s0.w) + (wf[4] * s1.x + wf[5] * s1.y) + (wf[6] * s1.z + wf[7] * s1.w); } }
#pragma unroll
        for (int b = 0; b < 4; ++b) a[b] = wave_sum(a[b]);
        if (F.lane < 4) dst[F.lane * ld + nn] = (F.lane == 0) ? a[0] : (F.lane == 1) ? a[1] : (F.lane == 2) ? a[2] : a[3];
    }
}
__device__ __forceinline__ void gmlp_unit(Ctx& F, int ch) {
    const bf16* proj = (const bf16*)(F.ws + WS_PROJ) + (size_t)ch * CHUNK * NMIX; bf16* ycat = (bf16*)(F.ws + WS_YCAT) + (size_t)ch * CHUNK * D;
    int lane_ = F.lane; asm volatile("" : "+v"(lane_));
    const int lane = lane_, w = F.wave, fr = lane & 15, fq = lane >> 4;
    {
        const int c0 = 8 * lane; float g8[8], b8[8];
        { const f32x4 a = *(const f32x4*)(F.in[11] + c0), b = *(const f32x4*)(F.in[11] + c0 + 4), c = *(const f32x4*)(F.in[12] + c0), d = *(const f32x4*)(F.in[12] + c0 + 4);
#pragma unroll
          for (int j = 0; j < 4; ++j) { g8[j] = a[j]; g8[4 + j] = b[j]; b8[j] = c[j]; b8[4 + j] = d[j]; } }
#pragma unroll
        for (int gi = 0; gi < 2; ++gi) {
            float vals[8][8];
#pragma unroll
            for (int i = 0; i < 8; ++i) {
                const v4u raw = *(const GAS v4u*)(proj + (size_t)(16 * w + 8 * gi + i) * NMIX + 1024 + c0);
                float xv[8] = {bflo(raw.x), bfhi(raw.x), bflo(raw.y), bfhi(raw.y), bflo(raw.z), bfhi(raw.z), bflo(raw.w), bfhi(raw.w)};
                float s = ((xv[0] + xv[1]) + (xv[2] + xv[3])) + ((xv[4] + xv[5]) + (xv[6] + xv[7]));
                const float mean = wave_sum(s) * (1.0f / 512.0f); float q = 0.f;
#pragma unroll
                for (int j = 0; j < 8; ++j) { xv[j] -= mean; q += xv[j] * xv[j]; }
                const float rstd = rsqrtf(wave_sum(q) * (1.0f / 512.0f) + 1e-6f);
#pragma unroll
                for (int j = 0; j < 8; ++j) vals[i][j] = xv[j] * rstd * g8[j] + b8[j];
            }
            const int G = 2 * w + gi;
#pragma unroll
            for (int j = 0; j < 8; ++j) { const int c = c0 + j, sig = (c ^ (c >> 3)) & 15; v4u pkv;
                pkv.x = pk2(vals[0][j], vals[1][j]); pkv.y = pk2(vals[2][j], vals[3][j]); pkv.z = pk2(vals[4][j], vals[5][j]); pkv.w = pk2(vals[6][j], vals[7][j]);
                *(LAS v4u*)(F.lds + c * 256 + ((G ^ sig) << 4)) = pkv; }
            asm volatile("" ::: "memory"); __builtin_amdgcn_sched_barrier(0);
        }
    }
    __syncthreads();
    {
        const int h = w; const bf16* wsp = (const bf16*)(F.ws + WS_WSP) + (size_t)h * 128 * 128;
        const float* bsp = F.in[14] + h * 128;
#pragma unroll
        for (int mh = 0; mh < 2; ++mh) {
            f32x4 acc[4][4];
#pragma unroll
            for (int m = 0; m < 4; ++m)
#pragma unroll
                for (int n = 0; n < 4; ++n) acc[m][n] = (f32x4){0.f, 0.f, 0.f, 0.f};
#pragma unroll
            for (int kk = 0; kk < 4; ++kk) if (kk * 32 <= (mh * 4 + 3) * 16 + 15) {
                bf16x8 vb[4];
#pragma unroll
                for (int n = 0; n < 4; ++n) { const int c = h * 64 + n * 16 + fr, sig = (c ^ (c >> 3)) & 15, G = kk * 4 + fq; vb[n] = *(const LAS bf16x8*)(F.lds + c * 256 + ((G ^ sig) << 4)); }
#pragma unroll
                for (int mm = 0; mm < 4; ++mm) { const int m = mh * 4 + mm; if (kk * 32 <= m * 16 + 15) {
                    const bf16x8 wa = *(const GAS bf16x8*)(wsp + (size_t)(m * 16 + fr) * 128 + kk * 32 + fq * 8);
#pragma unroll
                    for (int n = 0; n < 4; ++n) acc[mm][n] = __builtin_amdgcn_mfma_f32_16x16x32_bf16(vb[n], wa, acc[mm][n], 0, 0, 0);
                } }
            }
#pragma unroll
            for (int mm = 0; mm < 4; ++mm) { const int t = (mh * 4 + mm) * 16 + fr; const float bt = bsp[t];
#pragma unroll
                for (int n = 0; n < 4; ++n) { const int c = 512 + h * 64 + n * 16 + 4 * fq;
                    const v2u ur = *(const GAS v2u*)(proj + (size_t)t * NMIX + c);
                    const f32x4 sv = acc[mm][n] + bt; v2u o; o.x = pk2(bflo(ur.x) * sv[0], bfhi(ur.x) * sv[1]); o.y = pk2(bflo(ur.y) * sv[2], bfhi(ur.y) * sv[3]);
                    *(GAS v2u*)(ycat + (size_t)t * D + c) = o; } }
            asm volatile("" ::: "memory"); __builtin_amdgcn_sched_barrier(0);
        }
    }
    __syncthreads();
}
template <int W> __device__ __forceinline__ void pool_stage1(const bf16* proj, LAS unsigned char* lds, int p0, int g, int hf, int lane) {
    const int cl = lane & 15, rq = lane >> 4, t0 = hf * 64 + rq * 16;
    const bf16* base = proj + g * 128 + cl * 8;
    float a[8] = {0.f, 0.f, 0.f, 0.f, 0.f, 0.f, 0.f, 0.f};
#define POOL_UNPK(xv, q) const float xv[8] = {bflo(q.x), bfhi(q.x), bflo(q.y), bfhi(q.y), bflo(q.z), bfhi(q.z), bflo(q.w), bfhi(q.w)}
#define POOL_LD(dst, t) v4u dst = *(const GAS v4u*)(base + (ptrdiff_t)((t) < -p0 ? -p0 : (t)) * NMIX); if (p0 + (t) < 0) dst = (v4u){0u, 0u, 0u, 0u}
#pragma unroll
    for (int r = 0; r < W - 1; ++r) { POOL_LD(q, t0 - (W - 1) + r); POOL_UNPK(xv, q);
#pragma unroll
        for (int j = 0; j < 8; ++j) a[j] += xv[j]; }
    asm volatile("" ::: "memory"); __builtin_amdgcn_sched_barrier(0);
#pragma unroll
    for (int i0 = 0; i0 < 16; i0 += 4) {
#pragma unroll
        for (int ii = 0; ii < 4; ++ii) { const int i = i0 + ii, t = t0 + i, pos = p0 + t; POOL_LD(qn, t); POOL_LD(qo, t - (W - 1)); POOL_UNPK(xv, qn); POOL_UNPK(xo, qo);
            const int cnt = (pos + 1 < W) ? pos + 1 : W; const float inv = 1.0f / (float)cnt; float o[8];
#pragma unroll
            for (int j = 0; j < 8; ++j) { a[j] += xv[j]; o[j] = a[j] * inv - xv[j]; a[j] -= xo[j]; }
            v4u pkv; pkv.x = pk2(o[0], o[1]); pkv.y = pk2(o[2], o[3]); pkv.z = pk2(o[4], o[5]); pkv.w = pk2(o[6], o[7]);
            *(LAS v4u*)(lds + g * 32768 + t * 256 + ((cl ^ (t & 15)) << 4)) = pkv; }
        asm volatile("" ::: "memory"); __builtin_amdgcn_sched_barrier(0);
    }
#undef POOL_LD
#undef POOL_UNPK
}
__device__ __forceinline__ void pool_unit(Ctx& F, int ch) {
    const bf16* proj = (const bf16*)(F.ws + WS_PROJ) + (size_t)ch * CHUNK * NMIX; bf16* ycat = (bf16*)(F.ws + WS_YCAT) + (size_t)ch * CHUNK * D;
    int lane_ = F.lane; asm volatile("" : "+v"(lane_));
    const int lane = lane_, w = F.wave, fr = lane & 15, fq = lane >> 4, g = w >> 1, hf = w & 1, p0 = (ch * CHUNK) & (SEQ - 1);
#if !defined(DBG_POOL) || DBG_POOL == 1
    if (g == 0) pool_stage1<2>(proj, F.lds, p0, 0, hf, lane);
    else if (g == 1) pool_stage1<4>(proj, F.lds, p0, 1, hf, lane);
    else if (g == 2) pool_stage1<8>(proj, F.lds, p0, 2, hf, lane);
    else pool_stage1<16>(proj, F.lds, p0, 3, hf, lane);
#endif
    __syncthreads();
#if !defined(DBG_POOL) || DBG_POOL == 2
    {
        const int dh = hf; const bf16* wpt = (const bf16*)(F.ws + WS_WPT) + (size_t)g * 128 * 128;
        const float* psc = F.in[10] + g * 128 + dh * 64;
#pragma unroll
        for (int mh = 0; mh < 2; ++mh) {
            f32x4 acc[4][4];
#pragma unroll
            for (int m = 0; m < 4; ++m)
#pragma unroll
                for (int n = 0; n < 4; ++n) acc[m][n] = (f32x4){0.f, 0.f, 0.f, 0.f};
#pragma unroll
            for (int kk = 0; kk < 4; ++kk) {
                bf16x8 wb[4];
#pragma unroll
                for (int n = 0; n < 4; ++n) wb[n] = *(const GAS bf16x8*)(wpt + (size_t)(dh * 64 + n * 16 + fr) * 128 + kk * 32 + fq * 8);
#pragma unroll
                for (int mm = 0; mm < 4; ++mm) { const int t = (mh * 4 + mm) * 16 + fr, G = kk * 4 + fq;
                    const bf16x8 pa = *(const LAS bf16x8*)(F.lds + g * 32768 + t * 256 + ((G ^ (t & 15)) << 4));
#pragma unroll
                    for (int n = 0; n < 4; ++n) acc[mm][n] = __builtin_amdgcn_mfma_f32_16x16x32_bf16(wb[n], pa, acc[mm][n], 0, 0, 0); }
            }
#pragma unroll
            for (int n = 0; n < 4; ++n) { const f32x4 sc = *(const f32x4*)(psc + n * 16 + 4 * fq);
#pragma unroll
                for (int mm = 0; mm < 4; ++mm) { const int t = (mh * 4 + mm) * 16 + fr; const f32x4 v = acc[mm][n] * sc; v2u o; o.x = pk2(v[0], v[1]); o.y = pk2(v[2], v[3]);
                    *(GAS v2u*)(ycat + (size_t)t * D + g * 128 + dh * 64 + n * 16 + 4 * fq) = o; } }
            asm volatile("" ::: "memory"); __builtin_amdgcn_sched_barrier(0);
        }
    }
#endif
    __syncthreads();
}
__device__ __forceinline__ void phase5(Ctx& F) {
#if !defined(DBG_P5) || DBG_P5 == 1
    for (int u = F.bid; u < NCHUNK; u += F.G) gmlp_unit(F, u);
#endif
#if !defined(DBG_P5) || DBG_P5 == 2
    for (int u = F.bid; u < NCHUNK; u += F.G) pool_unit(F, u);
#endif
}
__device__ __forceinline__ void phase9(Ctx& F) {
    const int gw = F.bid * NWAVES + F.wave, NGW = F.G * NWAVES; const float* ng = F.in[19];
    for (int row = gw; row < M; row += NGW) {
        GAS f32x4* xr = (GAS f32x4*)(F.out + (size_t)row * D) + F.lane; f32x4 v[4]; float ss = 0.f;
#pragma unroll
        for (int j = 0; j < 4; ++j) { v[j] = xr[64 * j]; ss += (v[j].x * v[j].x + v[j].y * v[j].y) + (v[j].z * v[j].z + v[j].w * v[j].w); }
        const float r = rsqrtf(wave_sum(ss) * (1.0f / D) + 1e-6f);
#pragma unroll
        for (int j = 0; j < 4; ++j) xr[64 * j] = v[j] * r * *(const f32x4*)(ng + 4 * F.lane + 256 * j);
    }
}
struct Args { const float* in[20]; float* out; unsigned char* ws; int ph_lo, ph_hi; };
__global__ void __launch_bounds__(NTHREADS, 2) mk_fwd(Args args) {
    extern __shared__ __attribute__((aligned(16))) unsigned char lds_raw[];
    cg::grid_group grid = cg::this_grid();
    Ctx F;
    F.lds = (LAS unsigned char*)lds_raw; F.tid = threadIdx.x; F.lane = F.tid & 63; F.wave = __builtin_amdgcn_readfirstlane(F.tid >> 6); F.bid = blockIdx.x; F.G = gridDim.x;
#pragma unroll
    for (int i = 0; i < 20; ++i) F.in[i] = args.in[i];
    F.out = args.out; F.ws = args.ws;
    const int lo = args.ph_lo, hi = args.ph_hi;
#ifdef DBG_ONLY
#define IN(k) ((k) == DBG_ONLY && lo <= (k) && (k) < hi)
#else
#define IN(k) (lo <= (k) && (k) < hi)
#endif
#define SEAM(k) do { if (IN(k) && IN((k) + 1)) xcd_barrier(bar); } while (0)
    if (F.tid < 4) ((volatile LAS unsigned*)(F.lds + LDS_BAR_OFF))[F.tid] = 0u;
    __syncthreads();
    XcdBarrier bar; bar.bar = (unsigned*)(args.ws + WS_CTL); bar.x = 0; bar.st = nullptr;
    if (hi - lo > 1) bar = xcd_barrier_post((unsigned*)(args.ws + WS_CTL), (volatile LAS unsigned*)(F.lds + LDS_BAR_OFF));
    if (hi > 1000) grid.sync();
    unsigned char* ws = args.ws;
    const float* mod = (const float*)(ws + WS_MOD);
    if (IN(0)) { phase0(F); } SEAM(0);
    if (IN(1)) { phase1(F); } SEAM(1);
    if (IN(2)) {
        pg8::Gemm g{(const pg8::bf16_t*)(ws + WS_XS), (const pg8::bf16_t*)(ws + WS_W1A), M, NFF, D}; pg8::StaticOrder S; S.init(M, NFF, F.G, F.bid);
        pg8::EpiSwiglu E{(pg8::bf16_t*)(ws + WS_ACT), FF, (const float*)(ws + WS_RS0), (const float*)(ws + WS_SB1), NFF};
        pg8::gemm_phase<pg8::EpiSwiglu, pg8::StaticOrder, true, true>(F.lds, g, S, E);
    } SEAM(2);
    if (IN(3)) {
        pg8::Gemm g{(const pg8::bf16_t*)(ws + WS_ACT), (const pg8::bf16_t*)(ws + WS_W2A), M, D, FF}; pg8::StaticOrder S; S.init(M, D, F.G, F.bid);
        pg8::EpiRes<false> E{F.in[0], (float*)(ws + WS_X1), (pg8::bf16_t*)(ws + WS_XS), (float*)(ws + WS_RS1), mod + 2048, mod + 3072 + 1024, F.in[7], 0.5f, 0.f};
        pg8::gemm_phase<pg8::EpiRes<false>, pg8::StaticOrder, true, true>(F.lds, g, S, E);
    } SEAM(3);
    if (IN(4)) {
        pg8::Gemm g{(const pg8::bf16_t*)(ws + WS_XS), (const pg8::bf16_t*)(ws + WS_WMI), M, NMIX, D}; pg8::StaticOrder S; S.init(M, NMIX, F.G, F.bid);
        pg8::EpiProj E{(pg8::bf16_t*)(ws + WS_PROJ), NMIX, (const float*)(ws + WS_RS1), (const float*)(ws + WS_SB2), NMIX, 512};
        pg8::gemm_phase<pg8::EpiProj, pg8::StaticOrder, true, true>(F.lds, g, S, E);
    } SEAM(4);
    if (IN(5)) { phase5(F); } SEAM(5);
    if (IN(6)) {
        pg8::Gemm g{(const pg8::bf16_t*)(ws + WS_YCAT), (const pg8::bf16_t*)(ws + WS_WMO), M, D, D}; pg8::StaticOrder S; S.init(M, D, F.G, F.bid);
        pg8::EpiRes<false> E{(const float*)(ws + WS_X1), (float*)(ws + WS_X1), (pg8::bf16_t*)(ws + WS_XS), (float*)(ws + WS_RS2), mod + 3072 + 2048, mod + 6144 + 1024, F.in[16], 1.0f, 0.f};
        pg8::gemm_phase<pg8::EpiRes<false>, pg8::StaticOrder, true, true>(F.lds, g, S, E);
    } SEAM(6);
    if (IN(7)) {
        pg8::Gemm g{(const pg8::bf16_t*)(ws + WS_XS), (const pg8::bf16_t*)(ws + WS_W1B), M, NFF, D}; pg8::StaticOrder S; S.init(M, NFF, F.G, F.bid);
        pg8::EpiSwiglu E{(pg8::bf16_t*)(ws + WS_ACT), FF, (const float*)(ws + WS_RS2), (const float*)(ws + WS_SB3), NFF};
        pg8::gemm_phase<pg8::EpiSwiglu, pg8::StaticOrder, true, true>(F.lds, g, S, E);
    } SEAM(7);
    if (IN(8)) {
        pg8::Gemm g{(const pg8::bf16_t*)(ws + WS_ACT), (const pg8::bf16_t*)(ws + WS_W2B), M, D, FF}; pg8::StaticOrder S; S.init(M, D, F.G, F.bid);
        pg8::EpiRes<true> E{(const float*)(ws + WS_X1), F.out, nullptr, nullptr, mod + 6144 + 2048, nullptr, nullptr, 0.5f, 0.f};
        pg8::gemm_phase<pg8::EpiRes<true>, pg8::StaticOrder, true, true>(F.lds, g, S, E);
    } SEAM(8);
    if (IN(9)) { phase9(F); }
#undef IN
#undef SEAM
}
extern "C" void kernel_launch(void* const* d_in, const int* in_sizes, int n_in, void* d_out, int out_size, void* d_ws, size_t ws_size, hipStream_t stream) {
    static int grid = 0;
    if (grid == 0) {
        if (n_in != 20 || in_sizes[0] != M * D || out_size != M * D || ws_size < WS_END) { fprintf(stderr, "kernel_launch: unexpected shapes (n_in %d, in0 %d, out %d, ws %zu)\n", n_in, n_in > 0 ? in_sizes[0] : -1, out_size, ws_size); grid = -1; return; }
        int dev = 0, cus = 0, per_cu = 0;
        if (hipGetDevice(&dev) != hipSuccess || hipDeviceGetAttribute(&cus, hipDeviceAttributeMultiprocessorCount, dev) != hipSuccess) { grid = -1; return; }
        if (hipFuncSetAttribute((const void*)mk_fwd, hipFuncAttributeMaxDynamicSharedMemorySize, LDS_BYTES) != hipSuccess) { fprintf(stderr, "kernel_launch: hipFuncSetAttribute failed\n"); grid = -1; return; }
        if (hipOccupancyMaxActiveBlocksPerMultiprocessor(&per_cu, (const void*)mk_fwd, NTHREADS, LDS_BYTES) != hipSuccess || per_cu < 1) { fprintf(stderr, "kernel_launch: occupancy query says %d\n", per_cu); per_cu = 1; }
        (void)hipGetLastError();
        grid = cus * 1;
    }
    if (grid < 0) return;
    if (hipMemsetAsync((char*)d_ws + WS_CTL, 0, CTL_ZERO_BYTES, stream) != hipSuccess) { fprintf(stderr, "kernel_launch: memset failed\n"); return; }
    Args a{};
    for (int i = 0; i < 20; ++i) a.in[i] = (const float*)d_in[i];
    a.out = (float*)d_out; a.ws = (unsigned char*)d_ws;
#if MK_N_LAUNCHES == 1
    a.ph_lo = 0; a.ph_hi = NPHASE;
    void* kargs[] = {&a};
    hipError_t e = hipLaunchCooperativeKernel((const void*)mk_fwd, dim3(grid), dim3(NTHREADS), kargs, LDS_BYTES, stream);
    if (e != hipSuccess) fprintf(stderr, "kernel_launch: cooperative launch failed: %s (grid %d)\n", hipGetErrorString(e), grid);
#else
    for (int p = 0; p < NPHASE; ++p) { a.ph_lo = p; a.ph_hi = p + 1; hipLaunchKernelGGL(mk_fwd, dim3(grid), dim3(NTHREADS), LDS_BYTES, stream, a); }
#endif
}
```

```cpp
#include <hip/hip_runtime.h>
#include <hip/hip_cooperative_groups.h>
#include <cstdio>
#include <cstdint>
namespace cg = cooperative_groups;
namespace pg8 {
#define PG8_LAS __attribute__((address_space(3)))
typedef unsigned short bf16_t;
typedef short bf16x8 __attribute__((ext_vector_type(8)));
typedef float f32x4 __attribute__((ext_vector_type(4)));
typedef unsigned u32x4 __attribute__((ext_vector_type(4)));
constexpr int BM = 256, BK = 64, HALF = 128, HTB = HALF * BK * 2  , STAGE_BYTES = 8 * HTB, NXCD = 8, WGM = 8;

__host__ __device__ __forceinline__ int lds_byte(int r, int c) { const int st = (r >> 4) * 2 + (c >> 5), rr = r & 15, cc = c & 31, ob = rr * 64 + cc * 2; return st * 1024 + (ob ^ (((ob >> 9) & 1) << 5)); }
__host__ __device__ __forceinline__ void stage_rc(int b, int& R, int& C) { const int st = b / 1024, sb = b % 1024, swz = sb ^ (((sb >> 9) & 1) << 5); R = (st >> 1) * 16 + swz / 64; C = (st & 1) * 32 + (swz % 64) / 2; }
__host__ __device__ __forceinline__ int perm32(int rho) { const int n = rho >> 4, i = rho & 15; return 8 * (i >> 2) + 4 * n + (i & 3); }

struct Unit { int pm, pn; };
struct Gemm { const bf16_t* A; const bf16_t* Bt; int M, N, K; };

struct StaticOrder {
    int nM, nN, nwg, G, c;
    __host__ __device__ void init(int M, int N, int G_, int c_) { nM = M / BM; nN = N / BM; nwg = nM * nN; G = G_; c = c_; }
    __host__ __device__ bool next(int i, Unit& u) const {
        const long L = (long)i * G + c; if (L >= nwg) return false;
        int wgid = (int)L; { const int q = nwg / NXCD, r = nwg % NXCD, xcd = wgid % NXCD, off = wgid / NXCD; wgid = (xcd < r ? xcd * (q + 1) : r * (q + 1) + (xcd - r) * q) + off; }
        const int nig = WGM * nN, gid = wgid / nig, fm = gid * WGM, gsz = (nM - fm) < WGM ? (nM - fm) : WGM;
        u.pm = fm + ((wgid % nig) % gsz); u.pn = (wgid % nig) / gsz; return true;
    }
    __device__ __forceinline__ void a_ready(const Unit&) const {}
    __device__ __forceinline__ void done(const Unit&) const {}
};

__device__ __forceinline__ unsigned cvt_pk_bf16(float lo, float hi) { unsigned r; asm volatile("v_cvt_pk_bf16_f32 %0, %1, %2" : "=v"(r) : "v"(lo), "v"(hi)); return r; }
typedef float f32x2 __attribute__((ext_vector_type(2)));
__device__ __forceinline__ f32x2 gelu_pk(f32x2 v) {
    const f32x2 av = __builtin_elementwise_abs(v), d = av * 0.2316418882f + 1.0f;
    f32x2 t; t.x = __builtin_amdgcn_rcpf(d.x); t.y = __builtin_amdgcn_rcpf(d.y);
    f32x2 q = t * 0.5307027145f + (-0.7265760135f); q = q * t + 0.7107068705f; q = q * t + (-0.142248368f); q = q * t + 0.127414796f; q = q * t;
    const f32x2 s = (v * v) * (-0.72134752044f);
    f32x2 e; e.x = __builtin_amdgcn_exp2f(s.x); e.y = __builtin_amdgcn_exp2f(s.y);
    const f32x2 m = v * (q * e), r = v - m;
    f32x2 o; o.x = v.x < 0.f ? m.x : r.x; o.y = v.y < 0.f ? m.y : r.y; return o;
}

template <int ACT  > struct EpiBf16 {
    static constexpr bool PERM = true, AFTER_DRAIN = false; static_assert(ACT == 0 || ACT == 1, "EpiBf16: ACT is 0 (none) or 1 (gelu_pk)");
    bf16_t* O; int ldc; const float* bias; int split_cols; size_t split_stride; float scale0;
    __device__ __forceinline__ void operator()(const f32x4 (&acc)[2][2][4][2], const Unit& u, int wr, int wc, int fr, int fq) const {
        const int row0 = u.pm * BM + wr * 64 + fr; int colt = u.pn * BM; bf16_t* base = O;
        float sc = 1.f; if (split_cols) { const int t = colt / split_cols; base += (size_t)t * split_stride; colt -= t * split_cols; if (t == 0) sc = scale0; }
        const int col0 = colt + wc * 32 + 8 * fq, bcol0 = u.pn * BM + wc * 32 + 8 * fq;
        f32x4 bv[2][2];
#pragma unroll
        for (int bj = 0; bj < 2; ++bj)
#pragma unroll
            for (int n = 0; n < 2; ++n) bv[bj][n] = bias ? *(const f32x4*)(bias + bcol0 + bj * HALF + 4 * n) : (f32x4){0.f, 0.f, 0.f, 0.f};
#pragma unroll
        for (int ai = 0; ai < 2; ++ai)
#pragma unroll
            for (int m = 0; m < 4; ++m) { bf16_t* rowp = base + (size_t)(row0 + ai * HALF + m * 16) * ldc + col0;
#pragma unroll
                for (int bj = 0; bj < 2; ++bj) { f32x4 v0 = acc[ai][bj][m][0] + bv[bj][0], v1 = acc[ai][bj][m][1] + bv[bj][1];
                    if (ACT == 1) { f32x2 a = gelu_pk((f32x2){v0[0], v0[1]}), b = gelu_pk((f32x2){v0[2], v0[3]}), c = gelu_pk((f32x2){v1[0], v1[1]}), d = gelu_pk((f32x2){v1[2], v1[3]});
                        v0 = (f32x4){a.x, a.y, b.x, b.y}; v1 = (f32x4){c.x, c.y, d.x, d.y}; }
                    v0 = v0 * sc; v1 = v1 * sc; u32x4 w; w.x = cvt_pk_bf16(v0[0], v0[1]); w.y = cvt_pk_bf16(v0[2], v0[3]); w.z = cvt_pk_bf16(v1[0], v1[1]); w.w = cvt_pk_bf16(v1[2], v1[3]);
                    *(u32x4*)(rowp + bj * HALF) = w; } }
    }
};
__device__ __forceinline__ void row_factors(const float* rs, int row0, int fq, float (&rf)[2][4]) {
#pragma unroll
    for (int ai = 0; ai < 2; ++ai)
#pragma unroll
        for (int m = 0; m < 4; ++m) {
            const f32x4 p = *(const f32x4*)(rs + (size_t)(row0 + ai * HALF + m * 16) * 16 + 4 * fq);
            float s = (p[0] + p[1]) + (p[2] + p[3]);
            s += __shfl_xor(s, 16); s += __shfl_xor(s, 32);
            rf[ai][m] = rsqrtf(s * (1.0f / 1024.0f) + 1e-6f);
        }
}
__device__ __forceinline__ float sigmoid_fast(float v) { return __builtin_amdgcn_rcpf(1.0f + __builtin_amdgcn_exp2f(-1.44269504089f * v)); }
__device__ __forceinline__ float gelu_tanh(float v) { const float u = 0.7978845608f * (v + 0.044715f * v * v * v); return v * sigmoid_fast(2.0f * u); }

struct EpiSwiglu {
    static constexpr bool PERM = true, AFTER_DRAIN = false;
    bf16_t* O; int ldo; const float* rs; const float* sb; int nsb;
    __device__ __forceinline__ void operator()(const f32x4 (&acc)[2][2][4][2], const Unit& u, int wr, int wc, int fr, int fq) const {
        const int row0 = u.pm * BM + wr * 64 + fr, b = (u.pm * BM) >> 13;
        float rf[2][4]; row_factors(rs, row0, fq, rf);
        const float* sbp = sb + (size_t)b * nsb + u.pn * BM + wc * 32 + 8 * fq;
        f32x4 bg[2], bu[2];
#pragma unroll
        for (int n = 0; n < 2; ++n) { bg[n] = *(const f32x4*)(sbp + 4 * n); bu[n] = *(const f32x4*)(sbp + HALF + 4 * n); }
        const int col0 = u.pn * HALF + wc * 32 + 8 * fq;
#pragma unroll
        for (int ai = 0; ai < 2; ++ai)
#pragma unroll
            for (int m = 0; m < 4; ++m) {
                const float r = rf[ai][m]; float o[8];
#pragma unroll
                for (int n = 0; n < 2; ++n)
#pragma unroll
                    for (int j = 0; j < 4; ++j) { const float g = acc[ai][0][m][n][j] * r + bg[n][j], uu = acc[ai][1][m][n][j] * r + bu[n][j]; o[4 * n + j] = g * sigmoid_fast(g) * uu; }
                u32x4 w; w.x = cvt_pk_bf16(o[0], o[1]); w.y = cvt_pk_bf16(o[2], o[3]); w.z = cvt_pk_bf16(o[4], o[5]); w.w = cvt_pk_bf16(o[6], o[7]);
                *(u32x4*)(O + (size_t)(row0 + ai * HALF + m * 16) * ldo + col0) = w;
            }
    }
};
struct EpiProj {
    static constexpr bool PERM = true, AFTER_DRAIN = false;
    bf16_t* O; int ldo; const float* rs; const float* sb; int nsb; int gelu_from;
    __device__ __forceinline__ void operator()(const f32x4 (&acc)[2][2][4][2], const Unit& u, int wr, int wc, int fr, int fq) const {
        const int row0 = u.pm * BM + wr * 64 + fr, b = (u.pm * BM) >> 13;
        float rf[2][4]; row_factors(rs, row0, fq, rf);
        const int col0 = u.pn * BM + wc * 32 + 8 * fq;
        const float* sbp = sb + (size_t)b * nsb + col0;
        f32x4 bv[2][2];
#pragma unroll
        for (int bj = 0; bj < 2; ++bj)
#pragma unroll
            for (int n = 0; n < 2; ++n) bv[bj][n] = *(const f32x4*)(sbp + bj * HALF + 4 * n);
        const bool act = (u.pn * BM) >= gelu_from;
#pragma unroll
        for (int ai = 0; ai < 2; ++ai)
#pragma unroll
            for (int m = 0; m < 4; ++m) {
                const float r = rf[ai][m]; bf16_t* rowp = O + (size_t)(row0 + ai * HALF + m * 16) * ldo + col0;
#pragma unroll
                for (int bj = 0; bj < 2; ++bj) { float o[8];
#pragma unroll
                    for (int n = 0; n < 2; ++n)
#pragma unroll
                        for (int j = 0; j < 4; ++j) { const float v = acc[ai][bj][m][n][j] * r + bv[bj][n][j]; o[4 * n + j] = act ? gelu_tanh(v) : v; }
                    u32x4 w; w.x = cvt_pk_bf16(o[0], o[1]); w.y = cvt_pk_bf16(o[2], o[3]); w.z = cvt_pk_bf16(o[4], o[5]); w.w = cvt_pk_bf16(o[6], o[7]);
                    *(u32x4*)(rowp + bj * HALF) = w; }
            }
    }
};
__device__ __forceinline__ float bf_lo(unsigned w) { return __uint_as_float(w << 16); }
__device__ __forceinline__ float bf_hi(unsigned w) { return __uint_as_float(w & 0xffff0000u); }
template <bool FIRST, bool LAST> struct EpiRes {
    static constexpr bool PERM = true, AFTER_DRAIN = false;
    const float* xold_f; const bf16_t* xold_b; float* xnew_f; bf16_t* xnew_b; bf16_t* xs; float* rs; const float* gate; const float* scale_next; const float* ng; float coef, pad_;
    __device__ __forceinline__ void operator()(const f32x4 (&acc)[2][2][4][2], const Unit& u, int wr, int wc, int fr, int fq) const {
        const int row0 = u.pm * BM + wr * 64 + fr, b = (u.pm * BM) >> 13;
        const int col0 = u.pn * BM + wc * 32 + 8 * fq;
        f32x4 gt[2][2], gs[2][2];
#pragma unroll
        for (int bj = 0; bj < 2; ++bj)
#pragma unroll
            for (int n = 0; n < 2; ++n) { const int c = col0 + bj * HALF + 4 * n;
                gt[bj][n] = *(const f32x4*)(gate + (size_t)b * 9216 + c) * coef;
                if (!LAST) gs[bj][n] = *(const f32x4*)(ng + c) * (*(const f32x4*)(scale_next + (size_t)b * 9216 + c) + 1.0f); }
#pragma unroll
        for (int ai = 0; ai < 2; ++ai)
#pragma unroll
            for (int m = 0; m < 4; ++m) {
                const size_t off = (size_t)(row0 + ai * HALF + m * 16) * 1024 + col0; float ss = 0.f;
#pragma unroll
                for (int bj = 0; bj < 2; ++bj) { f32x4 xn[2];
                    if (FIRST) { xn[0] = *(const f32x4*)(xold_f + off + bj * HALF); xn[1] = *(const f32x4*)(xold_f + off + bj * HALF + 4); }
                    else { const u32x4 w = *(const u32x4*)(xold_b + off + bj * HALF); xn[0] = (f32x4){bf_lo(w.x), bf_hi(w.x), bf_lo(w.y), bf_hi(w.y)}; xn[1] = (f32x4){bf_lo(w.z), bf_hi(w.z), bf_lo(w.w), bf_hi(w.w)}; }
                    xn[0] += gt[bj][0] * acc[ai][bj][m][0]; xn[1] += gt[bj][1] * acc[ai][bj][m][1];
                    if (LAST) { *(f32x4*)(xnew_f + off + bj * HALF) = xn[0]; *(f32x4*)(xnew_f + off + bj * HALF + 4) = xn[1]; }
                    else { u32x4 w; w.x = cvt_pk_bf16(xn[0][0], xn[0][1]); w.y = cvt_pk_bf16(xn[0][2], xn[0][3]); w.z = cvt_pk_bf16(xn[1][0], xn[1][1]); w.w = cvt_pk_bf16(xn[1][2], xn[1][3]);
                        *(u32x4*)(xnew_b + off + bj * HALF) = w;
                        ss += (xn[0][0] * xn[0][0] + xn[0][1] * xn[0][1]) + (xn[0][2] * xn[0][2] + xn[0][3] * xn[0][3]) + (xn[1][0] * xn[1][0] + xn[1][1] * xn[1][1]) + (xn[1][2] * xn[1][2] + xn[1][3] * xn[1][3]);
                        const f32x4 a = xn[0] * gs[bj][0], c = xn[1] * gs[bj][1];
                        u32x4 v; v.x = cvt_pk_bf16(a[0], a[1]); v.y = cvt_pk_bf16(a[2], a[3]); v.z = cvt_pk_bf16(c[0], c[1]); v.w = cvt_pk_bf16(c[2], c[3]);
                        *(u32x4*)(xs + off + bj * HALF) = v; } }
                if (!LAST) { ss += __shfl_xor(ss, 16); ss += __shfl_xor(ss, 32);
                    if (fq == 0) rs[(size_t)(row0 + ai * HALF + m * 16) * 16 + u.pn * 4 + wc] = ss; }
            }
    }
};

template <class Epi, class Sched, bool ALIGN_EPI = false, bool SP2 = false>
__device__ __forceinline__ void gemm_phase(PG8_LAS unsigned char* lds, const Gemm g, const Sched S, const Epi E) {
    const int tid = threadIdx.x, wid = __builtin_amdgcn_readfirstlane(tid >> 6), lane = tid & 63, wr = wid >> 2, wc = wid & 3, fr = lane & 15, fq = lane >> 4;
    const int K = g.K, nt = K / BK;
    unsigned voffA[2], voffB[2];
#pragma unroll
    for (int i = 0; i < 2; ++i) { int R, C; stage_rc(tid * 16 + i * 8192, R, C); const int Rb = Epi::PERM ? ((R & ~31) + perm32(R & 31)) : R;
        voffA[i] = (unsigned)(R * K + C) * 2u; voffB[i] = (unsigned)(Rb * K + C) * 2u; }
    const size_t kstep = (size_t)(BK * 2);
    const size_t hstep = (size_t)HALF * K * 2;
    const size_t tstep = 2 * hstep;
    const unsigned ldsw = (unsigned)wid * 1024u;
    const int aoff = lds_byte(wr * 64 + fr, fq * 8), boff = lds_byte(wc * 32 + fr, fq * 8);
#define PG8_SA(b, h) (((b) * 2 + (h)) * HTB)
#define PG8_SB(b, h) ((4 + (b) * 2 + (h)) * HTB)
#define PG8_STAGE(bufoff, gbase, voff) do { _Pragma("unroll") for (int _i = 0; _i < 2; ++_i) \
        __builtin_amdgcn_global_load_lds((const unsigned*)((const char*)(gbase) + (voff)[_i]), (PG8_LAS unsigned*)(lds + (bufoff) + ldsw + _i * 8192), 16, 0, 0); } while (0)
#define PG8_LDA(dst, b, h) do { _Pragma("unroll") for (int m = 0; m < 4; ++m) _Pragma("unroll") for (int k = 0; k < 2; ++k) dst[m][k] = *(const PG8_LAS bf16x8*)(lds + PG8_SA(b, h) + aoff + m * 2048 + k * 1024); } while (0)
#define PG8_LDB(dst, b, h) do { _Pragma("unroll") for (int n = 0; n < 2; ++n) _Pragma("unroll") for (int k = 0; k < 2; ++k) dst[n][k] = *(const PG8_LAS bf16x8*)(lds + PG8_SB(b, h) + boff + n * 2048 + k * 1024); } while (0)
#define PG8_MMA(ai, bj, At, Bt) do { __builtin_amdgcn_s_setprio(1); _Pragma("unroll") for (int m = 0; m < 4; ++m) _Pragma("unroll") for (int n = 0; n < 2; ++n) _Pragma("unroll") for (int k = 0; k < 2; ++k) \
        acc[ai][bj][m][n] = __builtin_amdgcn_mfma_f32_16x16x32_bf16(Bt[n][k], At[m][k], acc[ai][bj][m][n], 0, 0, 0); __builtin_amdgcn_s_setprio(0); } while (0)
#define PG8_WAIT_V(n) asm volatile("s_waitcnt vmcnt(" #n ")" ::: "memory")
#define PG8_WAIT_L(n) asm volatile("s_waitcnt lgkmcnt(" #n ")" ::: "memory")
#define PG8_BAR __builtin_amdgcn_s_barrier()
#define PG8_SCHED __builtin_amdgcn_sched_barrier(0)
    Unit cur, nxt; int ui = 0;
    if (!S.next(0, cur)) return;
    f32x4 acc[2][2][4][2];
#pragma unroll
    for (int a = 0; a < 2; ++a)
#pragma unroll
        for (int b = 0; b < 2; ++b)
#pragma unroll
            for (int m = 0; m < 4; ++m)
#pragma unroll
                for (int n = 0; n < 2; ++n) acc[a][b][m][n] = (f32x4){0.f, 0.f, 0.f, 0.f};
    bf16x8 At[4][2], B0[2][2], B1[2][2];
    const char* cA = (const char*)g.A + (size_t)cur.pm * tstep; const char* cB = (const char*)g.Bt + (size_t)cur.pn * tstep;
    S.a_ready(cur);
    if constexpr (SP2) {
        PG8_STAGE(PG8_SB(0, 0), cB, voffB); PG8_STAGE(PG8_SB(0, 1), cB + hstep, voffB); PG8_STAGE(PG8_SA(0, 0), cA, voffA); PG8_STAGE(PG8_SA(0, 1), cA + hstep, voffA);
        if (wr == 1) PG8_BAR;
        PG8_WAIT_V(2); PG8_BAR;
        PG8_STAGE(PG8_SB(1, 0), cB + kstep, voffB); PG8_STAGE(PG8_SA(1, 0), cA + kstep, voffA); PG8_STAGE(PG8_SB(1, 1), cB + hstep + kstep, voffB);
        PG8_WAIT_V(6); PG8_BAR;
    } else {
        PG8_STAGE(PG8_SB(0, 0), cB, voffB); PG8_STAGE(PG8_SA(0, 0), cA, voffA); PG8_STAGE(PG8_SB(0, 1), cB + hstep, voffB); PG8_STAGE(PG8_SA(0, 1), cA + hstep, voffA);
        if (wr == 1) PG8_BAR;
        PG8_WAIT_V(4); PG8_BAR;
        PG8_STAGE(PG8_SB(1, 0), cB + kstep, voffB); PG8_STAGE(PG8_SA(1, 0), cA + kstep, voffA); PG8_STAGE(PG8_SB(1, 1), cB + hstep + kstep, voffB);
        PG8_WAIT_V(6); PG8_BAR;
    }
    for (;;) {
        const bool has_next = S.next(ui + 1, nxt);
        const char* nA = has_next ? (const char*)g.A + (size_t)nxt.pm * tstep : cA; const char* nB = has_next ? (const char*)g.Bt + (size_t)nxt.pn * tstep : cB;
        for (int t = 0; t < nt; t += 2) {
            const bool last = (t == nt - 2);
            const char* a1 = cA + (size_t)(t + 1) * kstep;
            const char* a2 = last ? nA : cA + (size_t)(t + 2) * kstep; const char* b2 = last ? nB : cB + (size_t)(t + 2) * kstep;
            const char* a3 = a2 + kstep; const char* b3 = b2 + kstep;
            if (last && has_next) S.a_ready(nxt);
            if constexpr (SP2) {
            PG8_LDB(B0, 0, 0); PG8_LDB(B1, 0, 1); PG8_SCHED; PG8_LDA(At, 0, 0); PG8_STAGE(PG8_SA(1, 1), a1 + hstep, voffA);
            PG8_WAIT_V(8); PG8_WAIT_L(0); PG8_BAR; PG8_MMA(0, 0, At, B0); PG8_MMA(0, 1, At, B1); PG8_BAR; PG8_SCHED;
            PG8_LDA(At, 0, 1); PG8_STAGE(PG8_SB(0, 0), b2, voffB); PG8_STAGE(PG8_SB(0, 1), b2 + hstep, voffB); PG8_STAGE(PG8_SA(0, 0), a2, voffA);
            PG8_WAIT_V(8); PG8_WAIT_L(0); PG8_BAR; PG8_MMA(1, 0, At, B0); PG8_MMA(1, 1, At, B1); PG8_BAR; PG8_SCHED;
            PG8_LDB(B0, 1, 0); PG8_LDB(B1, 1, 1); PG8_SCHED; PG8_LDA(At, 1, 0); PG8_STAGE(PG8_SA(0, 1), a2 + hstep, voffA);
            PG8_WAIT_V(8); PG8_WAIT_L(0); PG8_BAR; PG8_MMA(0, 0, At, B0); PG8_MMA(0, 1, At, B1); PG8_BAR; PG8_SCHED;
            PG8_LDA(At, 1, 1); PG8_STAGE(PG8_SB(1, 0), b3, voffB); PG8_STAGE(PG8_SB(1, 1), b3 + hstep, voffB); PG8_STAGE(PG8_SA(1, 0), a3, voffA);
            PG8_WAIT_V(8); PG8_WAIT_L(0); PG8_BAR; PG8_MMA(1, 0, At, B0); PG8_MMA(1, 1, At, B1); PG8_BAR; PG8_SCHED;
            } else {
            PG8_LDB(B0, 0, 0); PG8_SCHED; PG8_LDA(At, 0, 0); PG8_STAGE(PG8_SA(1, 1), a1 + hstep, voffA);
            PG8_WAIT_L(8); PG8_BAR; PG8_WAIT_L(0); PG8_MMA(0, 0, At, B0); PG8_BAR; PG8_SCHED;
            PG8_LDB(B1, 0, 1); PG8_STAGE(PG8_SB(0, 0), b2, voffB);
            PG8_BAR; PG8_WAIT_L(0); PG8_MMA(0, 1, At, B1); PG8_BAR;
            PG8_LDA(At, 0, 1); PG8_STAGE(PG8_SA(0, 0), a2, voffA);
            PG8_BAR; PG8_WAIT_L(0); PG8_MMA(1, 0, At, B0); PG8_BAR; PG8_SCHED;
            PG8_STAGE(PG8_SB(0, 1), b2 + hstep, voffB);
            PG8_WAIT_V(6); PG8_BAR; PG8_MMA(1, 1, At, B1); PG8_BAR;
            PG8_LDB(B0, 1, 0); PG8_SCHED; PG8_LDA(At, 1, 0); PG8_STAGE(PG8_SA(0, 1), a2 + hstep, voffA);
            PG8_WAIT_L(8); PG8_BAR; PG8_WAIT_L(0); PG8_MMA(0, 0, At, B0); PG8_BAR; PG8_SCHED;
            PG8_LDB(B1, 1, 1); PG8_STAGE(PG8_SB(1, 0), b3, voffB);
            PG8_BAR; PG8_WAIT_L(0); PG8_MMA(0, 1, At, B1); PG8_BAR;
            PG8_LDA(At, 1, 1); PG8_STAGE(PG8_SA(1, 0), a3, voffA);
            PG8_BAR; PG8_WAIT_L(0); PG8_MMA(1, 0, At, B0); PG8_BAR; PG8_SCHED;
            PG8_STAGE(PG8_SB(1, 1), b3 + hstep, voffB);
            PG8_WAIT_V(6); PG8_BAR; PG8_MMA(1, 1, At, B1); PG8_BAR;
            }
        }
        if constexpr (ALIGN_EPI) { if (wr == 0) PG8_BAR; }
        if constexpr (!Epi::AFTER_DRAIN) { E(acc, cur, wr, wc, fr, fq); S.done(cur); }
        if (!has_next) break;
#pragma unroll
        for (int a = 0; a < 2; ++a)
#pragma unroll
            for (int b = 0; b < 2; ++b)
#pragma unroll
                for (int m = 0; m < 4; ++m)
#pragma unroll
                    for (int n = 0; n < 2; ++n) acc[a][b][m][n] = (f32x4){0.f, 0.f, 0.f, 0.f};
        cur = nxt; cA = nA; cB = nB; ++ui;
        if constexpr (ALIGN_EPI) { if (wr == 1) PG8_BAR; }
    }
    PG8_WAIT_V(0);
    if constexpr (!ALIGN_EPI) { if (wr == 0) PG8_BAR; }
    PG8_BAR;
    if constexpr (Epi::AFTER_DRAIN) { E.fused(acc, cur, wr, wc, fr, fq, lds, wid, lane); S.done(cur); }
#undef PG8_SA
#undef PG8_SB
#undef PG8_STAGE
#undef PG8_LDA
#undef PG8_LDB
#undef PG8_MMA
#undef PG8_WAIT_V
#undef PG8_WAIT_L
#undef PG8_BAR
#undef PG8_SCHED
}
}
#ifndef MK_N_LAUNCHES
#define MK_N_LAUNCHES 1
#endif
constexpr int NWAVES = 8, NTHREADS = 512;
constexpr int BATCH = 4, SEQ = 8192, D = 1024, M = BATCH * SEQ, FF = 2816, NFF = 2 * FF, NMIX = 1536, NMOD = 9216, CHUNK = 128, NCHUNK = M / CHUNK;
constexpr int NPHASE = 10;
constexpr size_t MiB = 1u << 20;
constexpr size_t WS_CTL = 512 * 1024, CTL_ZERO_BYTES = 16384;
constexpr size_t WS_MOD = 0;
constexpr size_t WS_SB1 = 1 * MiB, WS_SB2 = WS_SB1 + 128 * 1024, WS_SB3 = WS_SB1 + 256 * 1024;
constexpr size_t WS_RS0 = 2 * MiB, WS_RS1 = 4 * MiB, WS_RS2 = 6 * MiB;
constexpr size_t WS_W1A = 8 * MiB, WS_W2A = 20 * MiB, WS_WMI = 26 * MiB, WS_WMO = 30 * MiB, WS_W1B = 32 * MiB, WS_W2B = 44 * MiB, WS_WPT = 50 * MiB, WS_WSP = 51 * MiB;
constexpr size_t WS_XS = 64 * MiB;
constexpr size_t WS_X1 = 128 * MiB;
constexpr size_t WS_ACT = 256 * MiB;
constexpr size_t WS_PROJ = 256 * MiB, WS_YCAT = 352 * MiB;
constexpr size_t WS_END = 432 * MiB;
constexpr int LDS_BAR_OFF = 131072;
constexpr int LDS_BYTES = 147456;

#define GAS __attribute__((address_space(1)))
#define LAS __attribute__((address_space(3)))
typedef unsigned short bf16;
typedef unsigned v4u __attribute__((ext_vector_type(4)));
typedef unsigned v2u __attribute__((ext_vector_type(2)));
typedef float f32x4 __attribute__((ext_vector_type(4)));
typedef float f32x2 __attribute__((ext_vector_type(2)));
typedef short bf16x8 __attribute__((ext_vector_type(8)));
#define LDS_WAIT() asm volatile("s_waitcnt lgkmcnt(0)" ::: "memory")
__device__ __forceinline__ unsigned f2bf(float f) { unsigned u = __builtin_bit_cast(unsigned, f); return (u + 0x7fffu + ((u >> 16) & 1u)) >> 16; }
__device__ __forceinline__ unsigned pk2(float lo, float hi) { return f2bf(lo) | (f2bf(hi) << 16); }
__device__ __forceinline__ float bflo(unsigned w) { return __uint_as_float(w << 16); }
__device__ __forceinline__ float bfhi(unsigned w) { return __uint_as_float(w & 0xffff0000u); }
__device__ __forceinline__ float wave_sum(float v) {
#pragma unroll
    for (int o = 1; o < 64; o <<= 1) v += __shfl_xor(v, o);
    return v;
}

#define XB_TMO      128
#define XB_XCNT(j)  (256  + 64 * (j))
#define XB_XSUB(j)  (1280 + 64 * (j))
#define XB_XGEN(j)  (2304 + 64 * (j))
#define XB_TOP      3328
#define XB_TOPGEN   3392
#define XCD_BAR_WORDS 3456
#define XB_SPIN_CAP (1u << 18)

__device__ __forceinline__ unsigned xb_ld(unsigned* p)              { return __hip_atomic_load(p, __ATOMIC_RELAXED, __HIP_MEMORY_SCOPE_AGENT); }
__device__ __forceinline__ unsigned xb_add(unsigned* p, unsigned v) { return __hip_atomic_fetch_add(p, v, __ATOMIC_RELAXED, __HIP_MEMORY_SCOPE_AGENT); }
__device__ __forceinline__ unsigned xb_xcc_id() { return (unsigned)__builtin_amdgcn_s_getreg((3 << 11) | 20) & 0xFu; }
#define XB_SPIN(cond, bar) do { unsigned _sp = 0; while (cond) { __builtin_amdgcn_s_sleep(1); \
    if ((++_sp & 255u) == 0u) { if (xb_ld(&(bar)[XB_TMO])) break; if (_sp > XB_SPIN_CAP) { atomicAdd(&(bar)[XB_TMO], 1u); break; } } } } while (0)

struct XcdBarrier {
    unsigned* bar; unsigned x;
    volatile LAS unsigned* st;
};

__device__ __forceinline__ XcdBarrier xcd_barrier_post(unsigned* bar, volatile LAS unsigned* st) {
    XcdBarrier b; b.bar = bar; b.x = xb_xcc_id(); b.st = st;
    if (threadIdx.x == 0) (void)xb_add(&bar[XB_XCNT(b.x)], 1u);
    return b;
}
__device__ __forceinline__ void xcd_barrier_complete(unsigned* bar, unsigned x, unsigned& nloc, unsigned& nx) {
    const unsigned G = gridDim.x * gridDim.y * gridDim.z;
    unsigned sum, cnt, mine, sp = 0u;
    for (;;) {
        sum = 0u; cnt = 0u; mine = 0u;
#pragma unroll
        for (unsigned j = 0; j < 16; ++j) { const unsigned c = xb_ld(&bar[XB_XCNT(j)]); sum += c; cnt += (c > 0u) ? 1u : 0u; mine = (j == x) ? c : mine; }
        if (sum == G) break;
        __builtin_amdgcn_s_sleep(1);
        if ((++sp & 255u) == 0u) { if (xb_ld(&bar[XB_TMO])) break; if (sp > XB_SPIN_CAP) { atomicAdd(&bar[XB_TMO], 1u); break; } }
    }
    nloc = mine > 0u ? mine : 1u; nx = cnt > 0u ? cnt : 1u;
}

__device__ __forceinline__ void xcd_barrier(const XcdBarrier& b) {
    asm volatile("s_waitcnt vmcnt(0)" ::: "memory");
    __syncthreads();
    if (threadIdx.x == 0) {
        unsigned* bar = b.bar;
        __builtin_amdgcn_s_waitcnt(0);
        unsigned nloc = b.st[0], nx = b.st[1];
        if (nloc == 0u) { xcd_barrier_complete(bar, b.x, nloc, nx); b.st[0] = nloc; b.st[1] = nx; }
        const unsigned old = xb_add(&bar[XB_XSUB(b.x)], 1u);
        const unsigned gen = old / nloc;
        if (old + 1u == (gen + 1u) * nloc) {
            __builtin_amdgcn_fence(__ATOMIC_RELEASE, "agent");
            asm volatile("s_waitcnt vmcnt(0)" ::: "memory");
            const unsigned og = xb_add(&bar[XB_TOP], 1u);
            const unsigned tg = og / nx;
            if (og + 1u == (tg + 1u) * nx) xb_add(&bar[XB_TOPGEN], 1u);
            else XB_SPIN(xb_ld(&bar[XB_TOPGEN]) == tg, bar);
            __builtin_amdgcn_fence(__ATOMIC_ACQUIRE, "agent");
            xb_add(&bar[XB_XGEN(b.x)], 1u);
            asm volatile("s_waitcnt vmcnt(0)" ::: "memory");
        } else {
            XB_SPIN(xb_ld(&bar[XB_XGEN(b.x)]) == gen, bar);
            __builtin_amdgcn_fence(__ATOMIC_ACQUIRE, "agent");
            asm volatile("s_waitcnt vmcnt(0)" ::: "memory");
        }
    }
    __syncthreads();
}

struct Ctx {
    LAS unsigned char* lds; int tid, lane, wave, bid, G;
    const float* in[20]; float* out; unsigned char* ws;
};

__device__ __forceinline__ void p0_transpose_item(const float* W, int K, int N, bf16* WT, int mode, LAS float* scr, int item, int lane) {
    const int nblk = N / 32, kb = item / nblk, nb = item % nblk, k0 = 64 * kb, n0 = 32 * nb;
    int r0 = n0;
    if (mode == 1) { r0 = (n0 < FF) ? (256 * (n0 >> 7) + (n0 & 127)) : (256 * ((n0 - FF) >> 7) + 128 + ((n0 - FF) & 127)); }
#pragma unroll 8
    for (int i = 0; i < 32; ++i) { const int kk = 2 * i + (lane >> 5); scr[kk * 33 + (lane & 31)] = W[(size_t)(k0 + kk) * N + n0 + (lane & 31)]; }
    LDS_WAIT(); asm volatile("" ::: "memory");
    const int c = lane & 7;
#pragma unroll
    for (int j = 0; j < 4; ++j) { const int n = (lane >> 3) + 8 * j; const LAS float* s = scr + (8 * c) * 33 + n;
        v4u o; o.x = pk2(s[0 * 33], s[1 * 33]); o.y = pk2(s[2 * 33], s[3 * 33]); o.z = pk2(s[4 * 33], s[5 * 33]); o.w = pk2(s[6 * 33], s[7 * 33]);
        *(GAS v4u*)(WT + (size_t)(r0 + n) * K + k0 + 8 * c) = o; }
    LDS_WAIT(); asm volatile("" ::: "memory");
}
__device__ __forceinline__ void p0_mod_item(Ctx& F, int item) {
    const float* c = F.in[1]; const float* wa = F.in[2]; const float* ba = F.in[3]; float* mod = (float*)(F.ws + WS_MOD);
    const int j0 = item * 128 + 2 * F.lane, kbeg = F.wave * 128;
    float a[4][2] = {};
#pragma unroll 8
    for (int k = 0; k < 128; ++k) {
        const f32x2 w = *(const f32x2*)(wa + (size_t)(kbeg + k) * NMOD + j0);
#pragma unroll
        for (int b = 0; b < 4; ++b) { const float cv = c[b * D + kbeg + k]; const float s = cv / (1.0f + __expf(-cv)); a[b][0] += s * w.x; a[b][1] += s * w.y; }
    }
    LAS float* red = (LAS float*)F.lds;
#pragma unroll
    for (int b = 0; b < 4; ++b) { red[(F.wave * 4 + b) * 128 + 2 * F.lane] = a[b][0]; red[(F.wave * 4 + b) * 128 + 2 * F.lane + 1] = a[b][1]; }
    __syncthreads();
    { const int b = F.tid >> 7, col = F.tid & 127; float s = ba[item * 128 + col];
#pragma unroll
      for (int w = 0; w < 8; ++w) s += red[(w * 4 + b) * 128 + col];
      mod[b * NMOD + item * 128 + col] = s; }
    __syncthreads();
}
__device__ __forceinline__ void phase0(Ctx& F) {
    for (int it = F.bid; it < NMOD / 128; it += F.G) p0_mod_item(F, it);
    LAS float* scr = (LAS float*)(F.lds + F.wave * 16384);
    const int gw = F.bid * NWAVES + F.wave, NGW = F.G * NWAVES;
    constexpr int I_1 = (D / 64) * (NFF / 32), I_2 = (FF / 64) * (D / 32), I_MI = (D / 64) * (NMIX / 32), I_MO = (D / 64) * (D / 32), I_P = 4 * 2 * 4;
    constexpr int NITEMS = 2 * I_1 + 2 * I_2 + I_MI + I_MO + I_P;
    for (int it = gw; it < NITEMS; it += NGW) {
        int r = it;
        if (r < I_1) { p0_transpose_item(F.in[5], D, NFF, (bf16*)(F.ws + WS_W1A), 1, scr, r, F.lane); continue; } r -= I_1;
        if (r < I_1) { p0_transpose_item(F.in[17], D, NFF, (bf16*)(F.ws + WS_W1B), 1, scr, r, F.lane); continue; } r -= I_1;
        if (r < I_2) { p0_transpose_item(F.in[6], FF, D, (bf16*)(F.ws + WS_W2A), 0, scr, r, F.lane); continue; } r -= I_2;
        if (r < I_2) { p0_transpose_item(F.in[18], FF, D, (bf16*)(F.ws + WS_W2B), 0, scr, r, F.lane); continue; } r -= I_2;
        if (r < I_MI) { p0_transpose_item(F.in[8], D, NMIX, (bf16*)(F.ws + WS_WMI), 0, scr, r, F.lane); continue; } r -= I_MI;
        if (r < I_MO) { p0_transpose_item(F.in[15], D, D, (bf16*)(F.ws + WS_WMO), 0, scr, r, F.lane); continue; } r -= I_MO;
        { const int g = r >> 3; p0_transpose_item(F.in[9] + (size_t)g * 128 * 128, 128, 128, (bf16*)(F.ws + WS_WPT) + (size_t)g * 128 * 128, 0, scr, r & 7, F.lane); }
    }
    { const float* wsp = F.in[13]; bf16* o = (bf16*)(F.ws + WS_WSP);
      for (int i = (F.bid * NTHREADS + F.tid) * 4; i < 8 * 128 * 128; i += F.G * NTHREADS * 4) {
          const f32x4 v = *(const f32x4*)(wsp + i); const int t = (i >> 7) & 127, s = i & 127;
          v2u w; w.x = pk2(s <= t ? v[0] : 0.f, s + 1 <= t ? v[1] : 0.f); w.y = pk2(s + 2 <= t ? v[2] : 0.f, s + 3 <= t ? v[3] : 0.f);
          *(GAS v2u*)(o + i) = w; } }
}
__device__ __forceinline__ void phase1(Ctx& F) {
    const float* mod = (const float*)(F.ws + WS_MOD);
    const int gw = F.bid * NWAVES + F.wave, NGW = F.G * NWAVES;
    const float* x = F.in[0]; const float* ng = F.in[4]; bf16* xs = (bf16*)(F.ws + WS_XS); float* rs0 = (float*)(F.ws + WS_RS0);
    for (int row = gw; row < M; row += NGW) {
        const int b = row >> 13; const GAS f32x4* xr = (const GAS f32x4*)(x + (size_t)row * D) + F.lane;
        GAS unsigned long long* o8 = (GAS unsigned long long*)(xs + (size_t)row * D) + F.lane; float ss = 0.f;
#pragma unroll
        for (int j = 0; j < 4; ++j) { const f32x4 v = xr[64 * j]; const int col = 4 * F.lane + 256 * j;
            const f32x4 gs = *(const f32x4*)(ng + col) * (*(const f32x4*)(mod + b * NMOD + 1024 + col) + 1.0f);
            ss += (v.x * v.x + v.y * v.y) + (v.z * v.z + v.w * v.w); const f32x4 h = v * gs;
            o8[64 * j] = (unsigned long long)pk2(h.x, h.y) | ((unsigned long long)pk2(h.z, h.w) << 32); }
        ss = wave_sum(ss);
        if (F.lane < 16) rs0[(size_t)row * 16 + F.lane] = ss * (1.0f / 16.0f);
    }
    for (int n = gw; n < NFF + NMIX + NFF; n += NGW) {
        const bf16* wrow; const float* sh; float* dst; int nn, ld;
        if (n < NFF) { nn = n; wrow = (const bf16*)(F.ws + WS_W1A); sh = mod + 0; dst = (float*)(F.ws + WS_SB1); ld = NFF; }
        else if (n < NFF + NMIX) { nn = n - NFF; wrow = (const bf16*)(F.ws + WS_WMI); sh = mod + 3072; dst = (float*)(F.ws + WS_SB2); ld = NMIX; }
        else { nn = n - NFF - NMIX; wrow = (const bf16*)(F.ws + WS_W1B); sh = mod + 6144; dst = (float*)(F.ws + WS_SB3); ld = NFF; }
        wrow += (size_t)nn * D; float a[4] = {0.f, 0.f, 0.f, 0.f};
#pragma unroll
        for (int h = 0; h < 2; ++h) { const int k0 = h * 512 + 8 * F.lane; const v4u w = *(const GAS v4u*)(wrow + k0);
            const float wf[8] = {bflo(w.x), bfhi(w.x), bflo(w.y), bfhi(w.y), bflo(w.z), bfhi(w.z), bflo(w.w), bfhi(w.w)};
#pragma unroll
            for (int b = 0; b < 4; ++b) { const f32x4 s0 = *(const f32x4*)(sh + b * NMOD + k0), s1 = *(const f32x4*)(sh + b * NMOD + k0 + 4);
                a[b] += (wf[0] * s0.x + wf[1] * s0.y) + (wf[2] * s0.z + wf[3] * s0.w) + (wf[4] * s1.x + wf[5] * s1.y) + (wf[6] * s1.z + wf[7] * s1.w); } }
#pragma unroll
        for (int b = 0; b < 4; ++b) a[b] = wave_sum(a[b]);
        if (F.lane < 4) dst[F.lane * ld + nn] = (F.lane == 0) ? a[0] : (F.lane == 1) ? a[1] : (F.lane == 2) ? a[2] : a[3];
    }
}
__device__ __forceinline__ void gmlp_unit(Ctx& F, int ch) {
    const bf16* proj = (const bf16*)(F.ws + WS_PROJ) + (size_t)ch * CHUNK * NMIX; bf16* ycat = (bf16*)(F.ws + WS_YCAT) + (size_t)ch * CHUNK * D;
    int lane_ = F.lane; asm volatile("" : "+v"(lane_));
    const int lane = lane_, w = F.wave, fr = lane & 15, fq = lane >> 4;
    {
        const int c0 = 8 * lane; float g8[8], b8[8];
        { const f32x4 a = *(const f32x4*)(F.in[11] + c0), b = *(const f32x4*)(F.in[11] + c0 + 4), c = *(const f32x4*)(F.in[12] + c0), d = *(const f32x4*)(F.in[12] + c0 + 4);
#pragma unroll
          for (int j = 0; j < 4; ++j) { g8[j] = a[j]; g8[4 + j] = b[j]; b8[j] = c[j]; b8[4 + j] = d[j]; } }
#pragma unroll
        for (int gi = 0; gi < 2; ++gi) {
            float vals[8][8];
#pragma unroll
            for (int i = 0; i < 8; ++i) {
                const v4u raw = *(const GAS v4u*)(proj + (size_t)(16 * w + 8 * gi + i) * NMIX + 1024 + c0);
                float xv[8] = {bflo(raw.x), bfhi(raw.x), bflo(raw.y), bfhi(raw.y), bflo(raw.z), bfhi(raw.z), bflo(raw.w), bfhi(raw.w)};
                float s = ((xv[0] + xv[1]) + (xv[2] + xv[3])) + ((xv[4] + xv[5]) + (xv[6] + xv[7]));
                const float mean = wave_sum(s) * (1.0f / 512.0f); float q = 0.f;
#pragma unroll
                for (int j = 0; j < 8; ++j) { xv[j] -= mean; q += xv[j] * xv[j]; }
                const float rstd = rsqrtf(wave_sum(q) * (1.0f / 512.0f) + 1e-6f);
#pragma unroll
                for (int j = 0; j < 8; ++j) vals[i][j] = xv[j] * rstd * g8[j] + b8[j];
            }
            const int G = 2 * w + gi;
#pragma unroll
            for (int j = 0; j < 8; ++j) { const int c = c0 + j, sig = (c ^ (c >> 3)) & 15; v4u pkv;
                pkv.x = pk2(vals[0][j], vals[1][j]); pkv.y = pk2(vals[2][j], vals[3][j]); pkv.z = pk2(vals[4][j], vals[5][j]); pkv.w = pk2(vals[6][j], vals[7][j]);
                *(LAS v4u*)(F.lds + c * 256 + ((G ^ sig) << 4)) = pkv; }
            asm volatile("" ::: "memory"); __builtin_amdgcn_sched_barrier(0);
        }
    }
    __syncthreads();
    {
        const int h = w; const bf16* wsp = (const bf16*)(F.ws + WS_WSP) + (size_t)h * 128 * 128;
        const float* bsp = F.in[14] + h * 128;
#pragma unroll
        for (int mh = 0; mh < 2; ++mh) {
            f32x4 acc[4][4];
#pragma unroll
            for (int m = 0; m < 4; ++m)
#pragma unroll
                for (int n = 0; n < 4; ++n) acc[m][n] = (f32x4){0.f, 0.f, 0.f, 0.f};
#pragma unroll
            for (int kk = 0; kk < 4; ++kk) if (kk * 32 <= (mh * 4 + 3) * 16 + 15) {
                bf16x8 vb[4];
#pragma unroll
                for (int n = 0; n < 4; ++n) { const int c = h * 64 + n * 16 + fr, sig = (c ^ (c >> 3)) & 15, G = kk * 4 + fq; vb[n] = *(const LAS bf16x8*)(F.lds + c * 256 + ((G ^ sig) << 4)); }
#pragma unroll
                for (int mm = 0; mm < 4; ++mm) { const int m = mh * 4 + mm; if (kk * 32 <= m * 16 + 15) {
                    const bf16x8 wa = *(const GAS bf16x8*)(wsp + (size_t)(m * 16 + fr) * 128 + kk * 32 + fq * 8);
#pragma unroll
                    for (int n = 0; n < 4; ++n) acc[mm][n] = __builtin_amdgcn_mfma_f32_16x16x32_bf16(vb[n], wa, acc[mm][n], 0, 0, 0);
                } }
            }
#pragma unroll
            for (int mm = 0; mm < 4; ++mm) { const int t = (mh * 4 + mm) * 16 + fr; const float bt = bsp[t];
#pragma unroll
                for (int n = 0; n < 4; ++n) { const int c = 512 + h * 64 + n * 16 + 4 * fq;
                    const v2u ur = *(const GAS v2u*)(proj + (size_t)t * NMIX + c);
                    const f32x4 sv = acc[mm][n] + bt; v2u o; o.x = pk2(bflo(ur.x) * sv[0], bfhi(ur.x) * sv[1]); o.y = pk2(bflo(ur.y) * sv[2], bfhi(ur.y) * sv[3]);
                    *(GAS v2u*)(ycat + (size_t)t * D + c) = o; } }
            asm volatile("" ::: "memory"); __builtin_amdgcn_sched_barrier(0);
        }
    }
    __syncthreads();
}
template <int W> __device__ __forceinline__ void pool_stage1(const bf16* proj, LAS unsigned char* lds, int p0, int g, int hf, int lane) {
    const int cl = lane & 15, rq = lane >> 4, t0 = hf * 64 + rq * 16;
    const bf16* base = proj + g * 128 + cl * 8;
    float a[8] = {0.f, 0.f, 0.f, 0.f, 0.f, 0.f, 0.f, 0.f};
#define POOL_UNPK(xv, q) const float xv[8] = {bflo(q.x), bfhi(q.x), bflo(q.y), bfhi(q.y), bflo(q.z), bfhi(q.z), bflo(q.w), bfhi(q.w)}
#define POOL_LD(dst, t) v4u dst = *(const GAS v4u*)(base + (ptrdiff_t)((t) < -p0 ? -p0 : (t)) * NMIX); if (p0 + (t) < 0) dst = (v4u){0u, 0u, 0u, 0u}
#pragma unroll
    for (int r = 0; r < W - 1; ++r) { POOL_LD(q, t0 - (W - 1) + r); POOL_UNPK(xv, q);
#pragma unroll
        for (int j = 0; j < 8; ++j) a[j] += xv[j]; }
    asm volatile("" ::: "memory"); __builtin_amdgcn_sched_barrier(0);
#pragma unroll
    for (int i0 = 0; i0 < 16; i0 += 4) {
#pragma unroll
        for (int ii = 0; ii < 4; ++ii) { const int i = i0 + ii, t = t0 + i, pos = p0 + t; POOL_LD(qn, t); POOL_LD(qo, t - (W - 1)); POOL_UNPK(xv, qn); POOL_UNPK(xo, qo);
            const int cnt = (pos + 1 < W) ? pos + 1 : W; const float inv = 1.0f / (float)cnt; float o[8];
#pragma unroll
            for (int j = 0; j < 8; ++j) { a[j] += xv[j]; o[j] = a[j] * inv - xv[j]; a[j] -= xo[j]; }
            v4u pkv; pkv.x = pk2(o[0], o[1]); pkv.y = pk2(o[2], o[3]); pkv.z = pk2(o[4], o[5]); pkv.w = pk2(o[6], o[7]);
            *(LAS v4u*)(lds + g * 32768 + t * 256 + ((cl ^ (t & 15)) << 4)) = pkv; }
        asm volatile("" ::: "memory"); __builtin_amdgcn_sched_barrier(0);
    }
#undef POOL_LD
#undef POOL_UNPK
}
__device__ __forceinline__ void pool_unit(Ctx& F, int ch) {
    const bf16* proj = (const bf16*)(F.ws + WS_PROJ) + (size_t)ch * CHUNK * NMIX; bf16* ycat = (bf16*)(F.ws + WS_YCAT) + (size_t)ch * CHUNK * D;
    int lane_ = F.lane; asm volatile("" : "+v"(lane_));
    const int lane = lane_, w = F.wave, fr = lane & 15, fq = lane >> 4, g = w >> 1, hf = w & 1, p0 = (ch * CHUNK) & (SEQ - 1);
#if !defined(DBG_POOL) || DBG_POOL == 1
    if (g == 0) pool_stage1<2>(proj, F.lds, p0, 0, hf, lane);
    else if (g == 1) pool_stage1<4>(proj, F.lds, p0, 1, hf, lane);
    else if (g == 2) pool_stage1<8>(proj, F.lds, p0, 2, hf, lane);
    else pool_stage1<16>(proj, F.lds, p0, 3, hf, lane);
#endif
    __syncthreads();
#if !defined(DBG_POOL) || DBG_POOL == 2
    {
        const int dh = hf; const bf16* wpt = (const bf16*)(F.ws + WS_WPT) + (size_t)g * 128 * 128;
        const float* psc = F.in[10] + g * 128 + dh * 64;
#pragma unroll
        for (int mh = 0; mh < 2; ++mh) {
            f32x4 acc[4][4];
#pragma unroll
            for (int m = 0; m < 4; ++m)
#pragma unroll
                for (int n = 0; n < 4; ++n) acc[m][n] = (f32x4){0.f, 0.f, 0.f, 0.f};
#pragma unroll
            for (int kk = 0; kk < 4; ++kk) {
                bf16x8 wb[4];
#pragma unroll
                for (int n = 0; n < 4; ++n) wb[n] = *(const GAS bf16x8*)(wpt + (size_t)(dh * 64 + n * 16 + fr) * 128 + kk * 32 + fq * 8);
#pragma unroll
                for (int mm = 0; mm < 4; ++mm) { const int t = (mh * 4 + mm) * 16 + fr, G = kk * 4 + fq;
                    const bf16x8 pa = *(const LAS bf16x8*)(F.lds + g * 32768 + t * 256 + ((G ^ (t & 15)) << 4));
#pragma unroll
                    for (int n = 0; n < 4; ++n) acc[mm][n] = __builtin_amdgcn_mfma_f32_16x16x32_bf16(wb[n], pa, acc[mm][n], 0, 0, 0); }
            }
#pragma unroll
            for (int n = 0; n < 4; ++n) { const f32x4 sc = *(const f32x4*)(psc + n * 16 + 4 * fq);
#pragma unroll
                for (int mm = 0; mm < 4; ++mm) { const int t = (mh * 4 + mm) * 16 + fr; const f32x4 v = acc[mm][n] * sc; v2u o; o.x = pk2(v[0], v[1]); o.y = pk2(v[2], v[3]);
                    *(GAS v2u*)(ycat + (size_t)t * D + g * 128 + dh * 64 + n * 16 + 4 * fq) = o; } }
            asm volatile("" ::: "memory"); __builtin_amdgcn_sched_barrier(0);
        }
    }
#endif
    __syncthreads();
}
__device__ __forceinline__ void phase5(Ctx& F) {
#if !defined(DBG_P5) || DBG_P5 == 1
    for (int u = F.bid; u < NCHUNK; u += F.G) gmlp_unit(F, u);
#endif
#if !defined(DBG_P5) || DBG_P5 == 2
    for (int u = F.bid; u < NCHUNK; u += F.G) pool_unit(F, u);
#endif
}
__device__ __forceinline__ void phase9(Ctx& F) {
    const int gw = F.bid * NWAVES + F.wave, NGW = F.G * NWAVES; const float* ng = F.in[19];
    for (int row = gw; row < M; row += NGW) {
        GAS f32x4* xr = (GAS f32x4*)(F.out + (size_t)row * D) + F.lane; f32x4 v[4]; float ss = 0.f;
#pragma unroll
        for (int j = 0; j < 4; ++j) { v[j] = xr[64 * j]; ss += (v[j].x * v[j].x + v[j].y * v[j].y) + (v[j].z * v[j].z + v[j].w * v[j].w); }
        const float r = rsqrtf(wave_sum(ss) * (1.0f / D) + 1e-6f);
#pragma unroll
        for (int j = 0; j < 4; ++j) xr[64 * j] = v[j] * r * *(const f32x4*)(ng + 4 * F.lane + 256 * j);
    }
}
struct Args { const float* in[20]; float* out; unsigned char* ws; int ph_lo, ph_hi; };
__global__ void __launch_bounds__(NTHREADS, 2) mk_fwd(Args args) {
    extern __shared__ __attribute__((aligned(16))) unsigned char lds_raw[];
    cg::grid_group grid = cg::this_grid();
    Ctx F;
    F.lds = (LAS unsigned char*)lds_raw; F.tid = threadIdx.x; F.lane = F.tid & 63; F.wave = __builtin_amdgcn_readfirstlane(F.tid >> 6); F.bid = blockIdx.x; F.G = gridDim.x;
#pragma unroll
    for (int i = 0; i < 20; ++i) F.in[i] = args.in[i];
    F.out = args.out; F.ws = args.ws;
    const int lo = args.ph_lo, hi = args.ph_hi;
#ifdef DBG_ONLY
#define IN(k) ((k) == DBG_ONLY && lo <= (k) && (k) < hi)
#else
#define IN(k) (lo <= (k) && (k) < hi)
#endif
#define SEAM(k) do { if (IN(k) && IN((k) + 1)) xcd_barrier(bar); } while (0)
    if (F.tid < 4) ((volatile LAS unsigned*)(F.lds + LDS_BAR_OFF))[F.tid] = 0u;
    __syncthreads();
    XcdBarrier bar; bar.bar = (unsigned*)(args.ws + WS_CTL); bar.x = 0; bar.st = nullptr;
    if (hi - lo > 1) bar = xcd_barrier_post((unsigned*)(args.ws + WS_CTL), (volatile LAS unsigned*)(F.lds + LDS_BAR_OFF));
    if (hi > 1000) grid.sync();
    unsigned char* ws = args.ws;
    const float* mod = (const float*)(ws + WS_MOD);
    if (IN(0)) { phase0(F); } SEAM(0);
    if (IN(1)) { phase1(F); } SEAM(1);
    if (IN(2)) {
        pg8::Gemm g{(const pg8::bf16_t*)(ws + WS_XS), (const pg8::bf16_t*)(ws + WS_W1A), M, NFF, D}; pg8::StaticOrder S; S.init(M, NFF, F.G, F.bid);
        pg8::EpiSwiglu E{(pg8::bf16_t*)(ws + WS_ACT), FF, (const float*)(ws + WS_RS0), (const float*)(ws + WS_SB1), NFF};
        pg8::gemm_phase<pg8::EpiSwiglu, pg8::StaticOrder, true, true>(F.lds, g, S, E);
    } SEAM(2);
    if (IN(3)) {
        pg8::Gemm g{(const pg8::bf16_t*)(ws + WS_ACT), (const pg8::bf16_t*)(ws + WS_W2A), M, D, FF}; pg8::StaticOrder S; S.init(M, D, F.G, F.bid);
        pg8::EpiRes<true, false> E{F.in[0], nullptr, nullptr, (pg8::bf16_t*)(ws + WS_X1), (pg8::bf16_t*)(ws + WS_XS), (float*)(ws + WS_RS1), mod + 2048, mod + 3072 + 1024, F.in[7], 0.5f, 0.f};
        pg8::gemm_phase<pg8::EpiRes<true, false>, pg8::StaticOrder, true, true>(F.lds, g, S, E);
    } SEAM(3);
    if (IN(4)) {
        pg8::Gemm g{(const pg8::bf16_t*)(ws + WS_XS), (const pg8::bf16_t*)(ws + WS_WMI), M, NMIX, D}; pg8::StaticOrder S; S.init(M, NMIX, F.G, F.bid);
        pg8::EpiProj E{(pg8::bf16_t*)(ws + WS_PROJ), NMIX, (const float*)(ws + WS_RS1), (const float*)(ws + WS_SB2), NMIX, 512};
        pg8::gemm_phase<pg8::EpiProj, pg8::StaticOrder, true, true>(F.lds, g, S, E);
    } SEAM(4);
    if (IN(5)) { phase5(F); } SEAM(5);
    if (IN(6)) {
        pg8::Gemm g{(const pg8::bf16_t*)(ws + WS_YCAT), (const pg8::bf16_t*)(ws + WS_WMO), M, D, D}; pg8::StaticOrder S; S.init(M, D, F.G, F.bid);
        pg8::EpiRes<false, false> E{nullptr, (const pg8::bf16_t*)(ws + WS_X1), nullptr, (pg8::bf16_t*)(ws + WS_X1), (pg8::bf16_t*)(ws + WS_XS), (float*)(ws + WS_RS2), mod + 3072 + 2048, mod + 6144 + 1024, F.in[16], 1.0f, 0.f};
        pg8::gemm_phase<pg8::EpiRes<false, false>, pg8::StaticOrder, true, true>(F.lds, g, S, E);
    } SEAM(6);
    if (IN(7)) {
        pg8::Gemm g{(const pg8::bf16_t*)(ws + WS_XS), (const pg8::bf16_t*)(ws + WS_W1B), M, NFF, D}; pg8::StaticOrder S; S.init(M, NFF, F.G, F.bid);
        pg8::EpiSwiglu E{(pg8::bf16_t*)(ws + WS_ACT), FF, (const float*)(ws + WS_RS2), (const float*)(ws + WS_SB3), NFF};
        pg8::gemm_phase<pg8::EpiSwiglu, pg8::StaticOrder, true, true>(F.lds, g, S, E);
    } SEAM(7);
    if (IN(8)) {
        pg8::Gemm g{(const pg8::bf16_t*)(ws + WS_ACT), (const pg8::bf16_t*)(ws + WS_W2B), M, D, FF}; pg8::StaticOrder S; S.init(M, D, F.G, F.bid);
        pg8::EpiRes<false, true> E{nullptr, (const pg8::bf16_t*)(ws + WS_X1), F.out, nullptr, nullptr, nullptr, mod + 6144 + 2048, nullptr, nullptr, 0.5f, 0.f};
        pg8::gemm_phase<pg8::EpiRes<false, true>, pg8::StaticOrder, true, true>(F.lds, g, S, E);
    } SEAM(8);
    if (IN(9)) { phase9(F); }
#undef IN
#undef SEAM
}
extern "C" void kernel_launch(void* const* d_in, const int* in_sizes, int n_in, void* d_out, int out_size, void* d_ws, size_t ws_size, hipStream_t stream) {
    static int grid = 0;
    if (grid == 0) {
        if (n_in != 20 || in_sizes[0] != M * D || out_size != M * D || ws_size < WS_END) { fprintf(stderr, "kernel_launch: unexpected shapes (n_in %d, in0 %d, out %d, ws %zu)\n", n_in, n_in > 0 ? in_sizes[0] : -1, out_size, ws_size); grid = -1; return; }
        int dev = 0, cus = 0, per_cu = 0;
        if (hipGetDevice(&dev) != hipSuccess || hipDeviceGetAttribute(&cus, hipDeviceAttributeMultiprocessorCount, dev) != hipSuccess) { grid = -1; return; }
        if (hipFuncSetAttribute((const void*)mk_fwd, hipFuncAttributeMaxDynamicSharedMemorySize, LDS_BYTES) != hipSuccess) { fprintf(stderr, "kernel_launch: hipFuncSetAttribute failed\n"); grid = -1; return; }
        if (hipOccupancyMaxActiveBlocksPerMultiprocessor(&per_cu, (const void*)mk_fwd, NTHREADS, LDS_BYTES) != hipSuccess || per_cu < 1) { fprintf(stderr, "kernel_launch: occupancy query says %d\n", per_cu); per_cu = 1; }
        (void)hipGetLastError();
        grid = cus * 1;
    }
    if (grid < 0) return;
    if (hipMemsetAsync((char*)d_ws + WS_CTL, 0, CTL_ZERO_BYTES, stream) != hipSuccess) { fprintf(stderr, "kernel_launch: memset failed\n"); return; }
    Args a{};
    for (int i = 0; i < 20; ++i) a.in[i] = (const float*)d_in[i];
    a.out = (float*)d_out; a.ws = (unsigned char*)d_ws;
#if MK_N_LAUNCHES == 1
    a.ph_lo = 0; a.ph_hi = NPHASE;
    void* kargs[] = {&a};
    hipError_t e = hipLaunchCooperativeKernel((const void*)mk_fwd, dim3(grid), dim3(NTHREADS), kargs, LDS_BYTES, stream);
    if (e != hipSuccess) fprintf(stderr, "kernel_launch: cooperative launch failed: %s (grid %d)\n", hipGetErrorString(e), grid);
#else
    for (int p = 0; p < NPHASE; ++p) { a.ph_lo = p; a.ph_hi = p + 1; hipLaunchKernelGGL(mk_fwd, dim3(grid), dim3(NTHREADS), LDS_BYTES, stream, a); }
#endif
}
```
